# Optimizing an MI355X kernel written in HIP

```python
import math
import jax, jax.numpy as jnp
from jax import lax
import numpy as np

D_MODEL = 1024
BATCH = 2
SEQ = 16384
DEPTH = 1
DEC_BATCH = 16
DEC_SEQ = 4096
PAST_LEN = 128

N_META = 16
GRID_W = 64
NA_HEADS = 8
NA_HEAD_DIM = 64
NA_WIDTH = NA_HEADS * NA_HEAD_DIM
NA_WIN_ROWS = 8
NA_WIN_COLS = 16
WA_Q_HEADS = 8
WA_KV_HEADS = 2
WA_HEAD_DIM = 64
WA_WIDTH = WA_Q_HEADS * WA_HEAD_DIM
WA_KV_WIDTH = WA_KV_HEADS * WA_HEAD_DIM
WINDOW = 128
BLOCK = 128
T5_BUCKETS = 32
T5_MAX_DIST = 128
RMS_EPS = 1e-6
NEG_INF = -1e30
IN_SIZES = (NA_WIDTH, NA_WIDTH, NA_WIDTH, NA_WIDTH,
            WA_WIDTH, WA_KV_WIDTH, WA_KV_WIDTH, WA_WIDTH,
            D_MODEL, D_MODEL)
IN_WIDTH = sum(IN_SIZES)

kernel_name = 'hybrid_na_window_gqa_encoder'


def rms_norm(x, g):
    x32 = x.astype(jnp.float32)
    y = x32 * lax.rsqrt(jnp.mean(x32 * x32, axis=-1, keepdims=True) + RMS_EPS)
    return (y * g.astype(jnp.float32)).astype(x.dtype)


def t5_bucket(rel):
    half = T5_BUCKETS // 2
    exact = half // 2
    ret = jnp.where(rel > 0, half, 0)
    n = jnp.abs(rel)
    nf = jnp.maximum(n, 1).astype(jnp.float32)
    large = exact + (jnp.log(nf / exact) / math.log(T5_MAX_DIST / exact)
                     * (half - exact)).astype(jnp.int32)
    large = jnp.minimum(large, half - 1)
    return ret + jnp.where(n < exact, n, large)


def neighbourhood_attention(q, k, v, rpb, n):
    B, _, H, hd = q.shape
    rows = n // GRID_W
    kr = min(NA_WIN_ROWS, rows)
    kc = NA_WIN_COLS
    scale = hd ** -0.5
    f32 = jnp.float32
    qm, km, vm = q[:, :N_META], k[:, :N_META], v[:, :N_META]
    qg = q[:, N_META:].reshape(B, rows, GRID_W, H, hd)
    kg = k[:, N_META:].reshape(B, rows, GRID_W, H, hd)
    vg = v[:, N_META:].reshape(B, rows, GRID_W, H, hd)
    cols = jnp.arange(GRID_W)
    col_start = jnp.clip(cols - kc // 2, 0, GRID_W - kc)
    col_idx = col_start[:, None] + jnp.arange(kc)[None, :]
    col_rel = col_idx - cols[:, None] + (NA_WIN_COLS - 1)
    rpb_cols = rpb.astype(f32)[:, :, col_rel]

    def one_row(i):
        rs = jnp.clip(i - kr // 2, 0, rows - kr)
        k_rows = lax.dynamic_slice_in_dim(kg, rs, kr, axis=1)
        v_rows = lax.dynamic_slice_in_dim(vg, rs, kr, axis=1)
        k_win = k_rows[:, :, col_idx]
        v_win = v_rows[:, :, col_idx]
        q_row = lax.dynamic_index_in_dim(qg, i, axis=1, keepdims=False)
        row_rel = rs + jnp.arange(kr) - i + (NA_WIN_ROWS - 1)
        bias = rpb_cols[:, row_rel].transpose(0, 2, 1, 3)
        s_win = jnp.einsum('bjhd,bajchd->bhjac', q_row, k_win).astype(f32) * scale + bias
        s_meta = jnp.einsum('bjhd,bmhd->bhjm', q_row, km).astype(f32) * scale
        logits = jnp.concatenate([s_win.reshape(B, H, GRID_W, kr * kc), s_meta], axis=-1)
        p = jax.nn.softmax(logits, axis=-1).astype(v.dtype)
        p_win = p[..., :kr * kc].reshape(B, H, GRID_W, kr, kc)
        p_meta = p[..., kr * kc:]
        return (jnp.einsum('bhjac,bajchd->bjhd', p_win, v_win)
                + jnp.einsum('bhjm,bmhd->bjhd', p_meta, vm))

    og = lax.map(one_row, jnp.arange(rows))
    og = jnp.moveaxis(og, 0, 1).reshape(B, n, H, hd)
    s_m = jnp.einsum('bqhd,bmhd->bhqm', qm, km).astype(f32) * scale
    p_m = jax.nn.softmax(s_m, axis=-1).astype(v.dtype)
    o_meta = jnp.einsum('bhqm,bmhd->bqhd', p_m, vm)
    return jnp.concatenate([o_meta, og], axis=1)


def window_attention(q, k, v, t5_bias, sink, n):
    B, _, HQ, hd = q.shape
    HKV = k.shape[2]
    G = HQ // HKV
    nb = n // BLOCK
    C = 3 * BLOCK
    scale = hd ** -0.5
    f32 = jnp.float32
    bias_tab = t5_bias.astype(f32)
    sink_g = sink.astype(f32).reshape(HKV, G)
    km, vm = k[:, :N_META], v[:, :N_META]

    qr = q[:, N_META:].reshape(B, nb, BLOCK, HKV, G, hd)

    def band(t):
        tp = jnp.pad(t[:, N_META:], ((0, 0), (BLOCK, BLOCK), (0, 0), (0, 0)))
        tp = tp.reshape(B, nb + 2, BLOCK, HKV, hd)
        return jnp.concatenate([tp[:, :-2], tp[:, 1:-1], tp[:, 2:]], axis=2)

    k_band, v_band = band(k), band(v)
    qq = jnp.arange(BLOCK)
    kk = jnp.arange(C)
    blk = jnp.arange(nb)
    rel = kk[None, :] - BLOCK - qq[:, None]
    key_idx = blk[:, None] * BLOCK + kk[None, :] - BLOCK
    visible = (jnp.abs(rel) <= WINDOW)[None] & ((key_idx >= 0) & (key_idx < n))[:, None, :]
    band_bias = bias_tab[t5_bucket(rel)].reshape(BLOCK, C, HKV, G).transpose(2, 3, 0, 1)
    q_pos = N_META + blk[:, None] * BLOCK + qq[None, :]
    meta_rel = jnp.arange(N_META)[None, None, :] - q_pos[:, :, None]
    meta_bias = bias_tab[t5_bucket(meta_rel)].reshape(nb, BLOCK, N_META, HKV, G).transpose(0, 3, 4, 1, 2)

    s_band = jnp.einsum('bnqkgd,bnckd->bnkgqc', qr, k_band).astype(f32) * scale + band_bias
    s_band = jnp.where(visible[:, None, None], s_band, NEG_INF)
    s_meta = jnp.einsum('bnqkgd,bmkd->bnkgqm', qr, km).astype(f32) * scale + meta_bias
    sink_col = jnp.broadcast_to(sink_g[None, None, :, :, None, None], (B, nb, HKV, G, BLOCK, 1))
    p = jax.nn.softmax(jnp.concatenate([s_band, s_meta, sink_col], axis=-1), axis=-1).astype(v.dtype)
    o_real = (jnp.einsum('bnkgqc,bnckd->bnqkgd', p[..., :C], v_band)
              + jnp.einsum('bnkgqm,bmkd->bnqkgd', p[..., C:C + N_META], vm))
    o_real = o_real.reshape(B, n, HQ, hd)

    nk = N_META + WINDOW
    qm = q[:, :N_META].reshape(B, N_META, HKV, G, hd)
    k_lead, v_lead = k[:, :nk], v[:, :nk]
    rel_m = jnp.arange(nk)[None, :] - jnp.arange(N_META)[:, None]
    bias_m = bias_tab[t5_bucket(rel_m)].reshape(N_META, nk, HKV, G).transpose(2, 3, 0, 1)
    s_m = jnp.einsum('bqkgd,bckd->bkgqc', qm, k_lead).astype(f32) * scale + bias_m
    s_m = jnp.where(jnp.abs(rel_m) <= WINDOW, s_m, NEG_INF)
    sink_m = jnp.broadcast_to(sink_g[None, :, :, None, None], (B, HKV, G, N_META, 1))
    p_m = jax.nn.softmax(jnp.concatenate([s_m, sink_m], axis=-1), axis=-1)[..., :nk].astype(v.dtype)
    o_meta = jnp.einsum('bkgqc,bckd->bqkgd', p_m, v_lead).reshape(B, N_META, HQ, hd)
    return jnp.concatenate([o_meta, o_real], axis=1)


def mixer_layer(h, norm_g, w_in, na_rpb, sink, w_proj_a, w_proj_b, w_out, t5_bias):
    B, L, _ = h.shape
    n = L - N_META
    u = rms_norm(h, norm_g)
    proj = u @ w_in
    cuts = [int(c) for c in np.cumsum(IN_SIZES)[:-1]]
    qa, ka, va, za, qb, kb, vb, zb, ga, gb = jnp.split(proj, cuts, axis=-1)
    o_a = neighbourhood_attention(qa.reshape(B, L, NA_HEADS, NA_HEAD_DIM),
                                  ka.reshape(B, L, NA_HEADS, NA_HEAD_DIM),
                                  va.reshape(B, L, NA_HEADS, NA_HEAD_DIM),
                                  na_rpb, n).reshape(B, L, NA_WIDTH)
    o_b = window_attention(qb.reshape(B, L, WA_Q_HEADS, WA_HEAD_DIM),
                           kb.reshape(B, L, WA_KV_HEADS, WA_HEAD_DIM),
                           vb.reshape(B, L, WA_KV_HEADS, WA_HEAD_DIM),
                           t5_bias, sink, n).reshape(B, L, WA_WIDTH)
    y_a = (o_a * jax.nn.silu(za)) @ w_proj_a
    y_b = (o_b * jax.nn.silu(zb)) @ w_proj_b
    merged = jax.nn.sigmoid(ga) * y_a + jax.nn.sigmoid(gb) * y_b
    return merged @ w_out


def encode(x, meta_tokens, norm_g, w_in, na_rpb, sink_logit, w_proj_a, w_proj_b, w_out, t5_bias, final_g):
    B = x.shape[0]
    meta = jnp.broadcast_to(meta_tokens.astype(x.dtype)[None], (B, N_META, x.shape[-1]))
    h = jnp.concatenate([meta, x], axis=1)
    for l in range(DEPTH):
        h = h + mixer_layer(h, norm_g[l], w_in[l], na_rpb[l], sink_logit[l],
                            w_proj_a[l], w_proj_b[l], w_out[l], t5_bias)
    return rms_norm(h[:, N_META:], final_g)


def setup_inputs(seed: int = 0) -> dict:
    key = jax.random.key(seed)
    ks = jax.random.split(key, 12)
    nrm = jax.random.normal
    return {
        'x_prompt': nrm(ks[0], (BATCH, SEQ, D_MODEL), jnp.float32),
        'x_sample': nrm(ks[1], (DEC_BATCH, DEC_SEQ, D_MODEL), jnp.float32),
        'meta_tokens': nrm(ks[2], (N_META, D_MODEL), jnp.float32),
        'norm_g': 1.0 + 0.05 * nrm(ks[3], (DEPTH, D_MODEL), jnp.float32),
        'w_in': nrm(ks[4], (DEPTH, D_MODEL, IN_WIDTH), jnp.float32) * D_MODEL ** -0.5,
        'na_rpb': 0.5 * nrm(ks[5], (DEPTH, NA_HEADS, 2 * NA_WIN_ROWS - 1, 2 * NA_WIN_COLS - 1), jnp.float32),
        'sink_logit': nrm(ks[6], (DEPTH, WA_Q_HEADS), jnp.float32),
        'w_proj_a': nrm(ks[7], (DEPTH, NA_WIDTH, D_MODEL), jnp.float32) * NA_WIDTH ** -0.5,
        'w_proj_b': nrm(ks[8], (DEPTH, WA_WIDTH, D_MODEL), jnp.float32) * WA_WIDTH ** -0.5,
        'w_out': nrm(ks[9], (DEPTH, D_MODEL, D_MODEL), jnp.float32) * D_MODEL ** -0.5,
        't5_bias': 0.5 * nrm(ks[10], (T5_BUCKETS, WA_Q_HEADS), jnp.float32),
        'final_g': 1.0 + 0.05 * nrm(ks[11], (D_MODEL,), jnp.float32),
    }


def reference(x_prompt, x_sample, meta_tokens, norm_g, w_in, na_rpb, sink_logit, w_proj_a, w_proj_b, w_out, t5_bias, final_g):
    y_prompt = encode(x_prompt, meta_tokens, norm_g, w_in, na_rpb, sink_logit,
                      w_proj_a, w_proj_b, w_out, t5_bias, final_g)
    y_sample = encode(x_sample, meta_tokens, norm_g, w_in, na_rpb, sink_logit,
                      w_proj_a, w_proj_b, w_out, t5_bias, final_g)
    return (y_prompt, y_sample)
```

```cpp
#define MK_N_LAUNCHES 6
#include <hip/hip_runtime.h>
#include <cstdio>
#include <cstdint>
namespace pg8 {
#define PG8_LAS __attribute__((address_space(3)))
typedef unsigned short bf16_t;
typedef short bf16x8 __attribute__((ext_vector_type(8)));
typedef float f32x4 __attribute__((ext_vector_type(4)));
typedef unsigned u32x4 __attribute__((ext_vector_type(4)));
constexpr int BM = 256, BK = 64, HALF = 128, HTB = HALF * BK * 2  , STAGE_BYTES = 8 * HTB, NXCD = 8, WGM = 8;

__host__ __device__ __forceinline__ int lds_byte(int r, int c) { const int st = (r >> 4) * 2 + (c >> 5), rr = r & 15, cc = c & 31, ob = rr * 64 + cc * 2; return st * 1024 + (ob ^ (((ob >> 9) & 1) << 5)); }
__host__ __device__ __forceinline__ void stage_rc(int b, int& R, int& C) { const int st = b / 1024, sb = b % 1024, swz = sb ^ (((sb >> 9) & 1) << 5); R = (st >> 1) * 16 + swz / 64; C = (st & 1) * 32 + (swz % 64) / 2; }
__host__ __device__ __forceinline__ int perm32(int rho) { const int n = rho >> 4, i = rho & 15; return 8 * (i >> 2) + 4 * n + (i & 3); }

struct Unit { int pm, pn; };
struct Gemm { const bf16_t* A; const bf16_t* Bt; int M, N, K, lda, ldb; };

struct StaticOrder {
    int nM, nN, nwg, G, c;
    __host__ __device__ void init(int M, int N, int G_, int c_) { nM = M / BM; nN = N / BM; nwg = nM * nN; G = G_; c = c_; }
    __host__ __device__ bool next(int i, Unit& u) const {
        const long L = (long)i * G + c; if (L >= nwg) return false;
        int wgid = (int)L; { const int q = nwg / NXCD, r = nwg % NXCD, xcd = wgid % NXCD, off = wgid / NXCD; wgid = (xcd < r ? xcd * (q + 1) : r * (q + 1) + (xcd - r) * q) + off; }
        const int nig = WGM * nN, gid = wgid / nig, fm = gid * WGM, gsz = (nM - fm) < WGM ? (nM - fm) : WGM;
        u.pm = fm + ((wgid % nig) % gsz); u.pn = (wgid % nig) / gsz; return true;
    }
    __device__ __forceinline__ void a_ready(const Unit&) const {}
    __device__ __forceinline__ void done(const Unit&) const {}
};

__device__ __forceinline__ unsigned cvt_pk_bf16(float lo, float hi) { unsigned r; asm volatile("v_cvt_pk_bf16_f32 %0, %1, %2" : "=v"(r) : "v"(lo), "v"(hi)); return r; }
__device__ __forceinline__ float bf_lo(unsigned w) { return __uint_as_float(w << 16); }
__device__ __forceinline__ float bf_hi(unsigned w) { return __uint_as_float(w & 0xffff0000u); }
__device__ __forceinline__ float sigmoidf_fast(float g) { return __builtin_amdgcn_rcpf(1.0f + __builtin_amdgcn_exp2f(-1.4426950408889634f * g)); }
struct EpiStoreBf16 {
    static constexpr bool PERM = true, AFTER_DRAIN = false;
    bf16_t* O; int ldc;
    __device__ __forceinline__ void operator()(const f32x4 (&acc)[2][2][4][2], const Unit& u, int wr, int wc, int fr, int fq) const {
        const int row0 = u.pm * BM + wr * 64 + fr; const int col0 = u.pn * BM + wc * 32 + 8 * fq;
#pragma unroll
        for (int ai = 0; ai < 2; ++ai)
#pragma unroll
            for (int m = 0; m < 4; ++m) { bf16_t* rowp = O + (size_t)(row0 + ai * HALF + m * 16) * ldc + col0;
#pragma unroll
                for (int bj = 0; bj < 2; ++bj) { const f32x4 v0 = acc[ai][bj][m][0], v1 = acc[ai][bj][m][1];
                    u32x4 w; w.x = cvt_pk_bf16(v0[0], v0[1]); w.y = cvt_pk_bf16(v0[2], v0[3]); w.z = cvt_pk_bf16(v1[0], v1[1]); w.w = cvt_pk_bf16(v1[2], v1[3]);
                    *(u32x4*)(rowp + bj * HALF) = w; } }
    }
};
template <bool ADD> struct EpiGate {
    static constexpr bool PERM = true, AFTER_DRAIN = false;
    bf16_t* P; int ldc; int gate_col;
    __device__ __forceinline__ void operator()(const f32x4 (&acc)[2][2][4][2], const Unit& u, int wr, int wc, int fr, int fq) const {
        const int row0 = u.pm * BM + wr * 64 + fr; const int col0 = u.pn * BM + wc * 32 + 8 * fq;
#pragma unroll
        for (int ai = 0; ai < 2; ++ai)
#pragma unroll
            for (int m = 0; m < 4; ++m) { bf16_t* rowp = P + (size_t)(row0 + ai * HALF + m * 16) * ldc + col0;
#pragma unroll
                for (int bj = 0; bj < 2; ++bj) { const f32x4 v0 = acc[ai][bj][m][0], v1 = acc[ai][bj][m][1];
                    const u32x4 gw = *(const u32x4*)(rowp + gate_col + bj * HALF);
                    float r[8];
                    r[0] = v0[0] * sigmoidf_fast(bf_lo(gw.x)); r[1] = v0[1] * sigmoidf_fast(bf_hi(gw.x));
                    r[2] = v0[2] * sigmoidf_fast(bf_lo(gw.y)); r[3] = v0[3] * sigmoidf_fast(bf_hi(gw.y));
                    r[4] = v1[0] * sigmoidf_fast(bf_lo(gw.z)); r[5] = v1[1] * sigmoidf_fast(bf_hi(gw.z));
                    r[6] = v1[2] * sigmoidf_fast(bf_lo(gw.w)); r[7] = v1[3] * sigmoidf_fast(bf_hi(gw.w));
                    if (ADD) { const u32x4 pw = *(const u32x4*)(rowp + bj * HALF);
                        r[0] += bf_lo(pw.x); r[1] += bf_hi(pw.x); r[2] += bf_lo(pw.y); r[3] += bf_hi(pw.y);
                        r[4] += bf_lo(pw.z); r[5] += bf_hi(pw.z); r[6] += bf_lo(pw.w); r[7] += bf_hi(pw.w); }
                    u32x4 w; w.x = cvt_pk_bf16(r[0], r[1]); w.y = cvt_pk_bf16(r[2], r[3]); w.z = cvt_pk_bf16(r[4], r[5]); w.w = cvt_pk_bf16(r[6], r[7]);
                    *(u32x4*)(rowp + bj * HALF) = w; } }
    }
};
struct EpiResF32 {
    static constexpr bool PERM = false, AFTER_DRAIN = false;
    const float* xa; const float* xb; int nsplit; float* out; int ldc;
    __device__ __forceinline__ void operator()(const f32x4 (&acc)[2][2][4][2], const Unit& u, int wr, int wc, int fr, int fq) const {
        const int row0 = u.pm * BM + wr * 64 + fr, col0 = u.pn * BM + wc * 32 + 4 * fq;
#pragma unroll
        for (int ai = 0; ai < 2; ++ai)
#pragma unroll
            for (int m = 0; m < 4; ++m) { const int row = row0 + ai * HALF + m * 16;
                const float* xr = (row < nsplit ? xa + (size_t)row * ldc : xb + (size_t)(row - nsplit) * ldc) + col0;
                float* rowp = out + (size_t)row * ldc + col0;
#pragma unroll
                for (int bj = 0; bj < 2; ++bj)
#pragma unroll
                    for (int n = 0; n < 2; ++n) *(f32x4*)(rowp + bj * HALF + n * 16) = acc[ai][bj][m][n] + *(const f32x4*)(xr + bj * HALF + n * 16); }
    }
};
template <class Epi, class Sched, bool ALIGN_EPI = false, bool SP2 = false>
__device__ __forceinline__ void gemm_phase(PG8_LAS unsigned char* lds, const Gemm g, const Sched& S, const Epi& E) {
    const int tid = threadIdx.x, wid = __builtin_amdgcn_readfirstlane(tid >> 6), lane = tid & 63, wr = wid >> 2, wc = wid & 3, fr = lane & 15, fq = lane >> 4;
    const int K = g.K, nt = K / BK;
    unsigned voffA[2], voffB[2];
#pragma unroll
    for (int i = 0; i < 2; ++i) { int R, C; stage_rc(tid * 16 + i * 8192, R, C); const int Rb = Epi::PERM ? ((R & ~31) + perm32(R & 31)) : R;
        voffA[i] = (unsigned)(R * g.lda + C) * 2u; voffB[i] = (unsigned)(Rb * g.ldb + C) * 2u; }
    const size_t kstep = (size_t)(BK * 2);
    const size_t hstepA = (size_t)HALF * g.lda * 2, hstepB = (size_t)HALF * g.ldb * 2;
    const size_t tstepA = 2 * hstepA, tstepB = 2 * hstepB;
    const unsigned ldsw = (unsigned)wid * 1024u;
    const int aoff = lds_byte(wr * 64 + fr, fq * 8), boff = lds_byte(wc * 32 + fr, fq * 8);
#define PG8_SA(b, h) (((b) * 2 + (h)) * HTB)
#define PG8_SB(b, h) ((4 + (b) * 2 + (h)) * HTB)
#define PG8_STAGE(bufoff, gbase, voff) do { _Pragma("unroll") for (int _i = 0; _i < 2; ++_i) \
        __builtin_amdgcn_global_load_lds((const unsigned*)((const char*)(gbase) + (voff)[_i]), (PG8_LAS unsigned*)(lds + (bufoff) + ldsw + _i * 8192), 16, 0, 0); } while (0)
#define PG8_LDA(dst, b, h) do { _Pragma("unroll") for (int m = 0; m < 4; ++m) _Pragma("unroll") for (int k = 0; k < 2; ++k) dst[m][k] = *(const PG8_LAS bf16x8*)(lds + PG8_SA(b, h) + aoff + m * 2048 + k * 1024); } while (0)
#define PG8_LDB(dst, b, h) do { _Pragma("unroll") for (int n = 0; n < 2; ++n) _Pragma("unroll") for (int k = 0; k < 2; ++k) dst[n][k] = *(const PG8_LAS bf16x8*)(lds + PG8_SB(b, h) + boff + n * 2048 + k * 1024); } while (0)
#define PG8_MMA(ai, bj, At, Bt) do { __builtin_amdgcn_s_setprio(1); _Pragma("unroll") for (int m = 0; m < 4; ++m) _Pragma("unroll") for (int n = 0; n < 2; ++n) _Pragma("unroll") for (int k = 0; k < 2; ++k) \
        acc[ai][bj][m][n] = __builtin_amdgcn_mfma_f32_16x16x32_bf16(Bt[n][k], At[m][k], acc[ai][bj][m][n], 0, 0, 0); __builtin_amdgcn_s_setprio(0); } while (0)
#define PG8_WAIT_V(n) asm volatile("s_waitcnt vmcnt(" #n ")" ::: "memory")
#define PG8_WAIT_L(n) asm volatile("s_waitcnt lgkmcnt(" #n ")" ::: "memory")
#define PG8_BAR __builtin_amdgcn_s_barrier()
#define PG8_SCHED __builtin_amdgcn_sched_barrier(0)
    Unit cur, nxt; int ui = 0;
    if (!S.next(0, cur)) return;
    f32x4 acc[2][2][4][2];
#pragma unroll
    for (int a = 0; a < 2; ++a)
#pragma unroll
        for (int b = 0; b < 2; ++b)
#pragma unroll
            for (int m = 0; m < 4; ++m)
#pragma unroll
                for (int n = 0; n < 2; ++n) acc[a][b][m][n] = (f32x4){0.f, 0.f, 0.f, 0.f};
    bf16x8 At[4][2], B0[2][2], B1[2][2];
    const char* cA = (const char*)g.A + (size_t)cur.pm * tstepA; const char* cB = (const char*)g.Bt + (size_t)cur.pn * tstepB;
    S.a_ready(cur);
    if constexpr (SP2) {
        PG8_STAGE(PG8_SB(0, 0), cB, voffB); PG8_STAGE(PG8_SB(0, 1), cB + hstepB, voffB); PG8_STAGE(PG8_SA(0, 0), cA, voffA); PG8_STAGE(PG8_SA(0, 1), cA + hstepA, voffA);
        if (wr == 1) PG8_BAR;
        PG8_WAIT_V(2); PG8_BAR;
        PG8_STAGE(PG8_SB(1, 0), cB + kstep, voffB); PG8_STAGE(PG8_SA(1, 0), cA + kstep, voffA); PG8_STAGE(PG8_SB(1, 1), cB + hstepB + kstep, voffB);
        PG8_WAIT_V(6); PG8_BAR;
    } else {
        PG8_STAGE(PG8_SB(0, 0), cB, voffB); PG8_STAGE(PG8_SA(0, 0), cA, voffA); PG8_STAGE(PG8_SB(0, 1), cB + hstepB, voffB); PG8_STAGE(PG8_SA(0, 1), cA + hstepA, voffA);
        if (wr == 1) PG8_BAR;
        PG8_WAIT_V(4); PG8_BAR;
        PG8_STAGE(PG8_SB(1, 0), cB + kstep, voffB); PG8_STAGE(PG8_SA(1, 0), cA + kstep, voffA); PG8_STAGE(PG8_SB(1, 1), cB + hstepB + kstep, voffB);
        PG8_WAIT_V(6); PG8_BAR;
    }
    for (;;) {
        const bool has_next = S.next(ui + 1, nxt);
        const char* nA = has_next ? (const char*)g.A + (size_t)nxt.pm * tstepA : cA; const char* nB = has_next ? (const char*)g.Bt + (size_t)nxt.pn * tstepB : cB;
        for (int t = 0; t < nt; t += 2) {
            const bool last = (t == nt - 2);
            const char* a1 = cA + (size_t)(t + 1) * kstep;
            const char* a2 = last ? nA : cA + (size_t)(t + 2) * kstep; const char* b2 = last ? nB : cB + (size_t)(t + 2) * kstep;
            const char* a3 = a2 + kstep; const char* b3 = b2 + kstep;
            if (last && has_next) S.a_ready(nxt);
            if constexpr (SP2) {
            PG8_LDB(B0, 0, 0); PG8_LDB(B1, 0, 1); PG8_SCHED; PG8_LDA(At, 0, 0); PG8_STAGE(PG8_SA(1, 1), a1 + hstepA, voffA);
            PG8_WAIT_V(8); PG8_WAIT_L(0); PG8_BAR; PG8_MMA(0, 0, At, B0); PG8_MMA(0, 1, At, B1); PG8_BAR; PG8_SCHED;
            PG8_LDA(At, 0, 1); PG8_STAGE(PG8_SB(0, 0), b2, voffB); PG8_STAGE(PG8_SB(0, 1), b2 + hstepB, voffB); PG8_STAGE(PG8_SA(0, 0), a2, voffA);
            PG8_WAIT_V(8); PG8_WAIT_L(0); PG8_BAR; PG8_MMA(1, 0, At, B0); PG8_MMA(1, 1, At, B1); PG8_BAR; PG8_SCHED;
            PG8_LDB(B0, 1, 0); PG8_LDB(B1, 1, 1); PG8_SCHED; PG8_LDA(At, 1, 0); PG8_STAGE(PG8_SA(0, 1), a2 + hstepA, voffA);
            PG8_WAIT_V(8); PG8_WAIT_L(0); PG8_BAR; PG8_MMA(0, 0, At, B0); PG8_MMA(0, 1, At, B1); PG8_BAR; PG8_SCHED;
            PG8_LDA(At, 1, 1); PG8_STAGE(PG8_SB(1, 0), b3, voffB); PG8_STAGE(PG8_SB(1, 1), b3 + hstepB, voffB); PG8_STAGE(PG8_SA(1, 0), a3, voffA);
            PG8_WAIT_V(8); PG8_WAIT_L(0); PG8_BAR; PG8_MMA(1, 0, At, B0); PG8_MMA(1, 1, At, B1); PG8_BAR; PG8_SCHED;
            } else {
            PG8_LDB(B0, 0, 0); PG8_SCHED; PG8_LDA(At, 0, 0); PG8_STAGE(PG8_SA(1, 1), a1 + hstepA, voffA);
            PG8_WAIT_L(8); PG8_BAR; PG8_WAIT_L(0); PG8_MMA(0, 0, At, B0); PG8_BAR; PG8_SCHED;
            PG8_LDB(B1, 0, 1); PG8_STAGE(PG8_SB(0, 0), b2, voffB);
            PG8_BAR; PG8_WAIT_L(0); PG8_MMA(0, 1, At, B1); PG8_BAR;
            PG8_LDA(At, 0, 1); PG8_STAGE(PG8_SA(0, 0), a2, voffA);
            PG8_BAR; PG8_WAIT_L(0); PG8_MMA(1, 0, At, B0); PG8_BAR; PG8_SCHED;
            PG8_STAGE(PG8_SB(0, 1), b2 + hstepB, voffB);
            PG8_WAIT_V(6); PG8_BAR; PG8_MMA(1, 1, At, B1); PG8_BAR;
            PG8_LDB(B0, 1, 0); PG8_SCHED; PG8_LDA(At, 1, 0); PG8_STAGE(PG8_SA(0, 1), a2 + hstepA, voffA);
            PG8_WAIT_L(8); PG8_BAR; PG8_WAIT_L(0); PG8_MMA(0, 0, At, B0); PG8_BAR; PG8_SCHED;
            PG8_LDB(B1, 1, 1); PG8_STAGE(PG8_SB(1, 0), b3, voffB);
            PG8_BAR; PG8_WAIT_L(0); PG8_MMA(0, 1, At, B1); PG8_BAR;
            PG8_LDA(At, 1, 1); PG8_STAGE(PG8_SA(1, 0), a3, voffA);
            PG8_BAR; PG8_WAIT_L(0); PG8_MMA(1, 0, At, B0); PG8_BAR; PG8_SCHED;
            PG8_STAGE(PG8_SB(1, 1), b3 + hstepB, voffB);
            PG8_WAIT_V(6); PG8_BAR; PG8_MMA(1, 1, At, B1); PG8_BAR;
            }
        }
        if constexpr (ALIGN_EPI) { if (wr == 0) PG8_BAR; }
        if constexpr (!Epi::AFTER_DRAIN) { E(acc, cur, wr, wc, fr, fq); S.done(cur); }
        if (!has_next) break;
#pragma unroll
        for (int a = 0; a < 2; ++a)
#pragma unroll
            for (int b = 0; b < 2; ++b)
#pragma unroll
                for (int m = 0; m < 4; ++m)
#pragma unroll
                    for (int n = 0; n < 2; ++n) acc[a][b][m][n] = (f32x4){0.f, 0.f, 0.f, 0.f};
        cur = nxt; cA = nA; cB = nB; ++ui;
        if constexpr (ALIGN_EPI) { if (wr == 1) PG8_BAR; }
    }
    PG8_WAIT_V(0);
    if constexpr (!ALIGN_EPI) { if (wr == 0) PG8_BAR; }
    PG8_BAR;
    if constexpr (Epi::AFTER_DRAIN) { E.fused(acc, cur, wr, wc, fr, fq, lds, wid, lane); S.done(cur); }
#undef PG8_SA
#undef PG8_SB
#undef PG8_STAGE
#undef PG8_LDA
#undef PG8_LDB
#undef PG8_MMA
#undef PG8_WAIT_V
#undef PG8_WAIT_L
#undef PG8_BAR
#undef PG8_SCHED
}
}

#ifndef PG8_SP2
#define PG8_SP2 true
#endif
#ifndef PG8_ALIGN
#define PG8_ALIGN true
#endif

constexpr int NWAVES = 8;
#ifndef MK_N_LAUNCHES
#define MK_N_LAUNCHES 1
#endif
constexpr int N_LAUNCHES = MK_N_LAUNCHES;
constexpr int PER_PHASE = 6;

constexpr int DM = 1024, NTOK = 98304, MP = 98560, NPROJ = 5376, N_PROMPT_ROWS = 32768, META_ROW = 98304;
constexpr int COL_QA = 0, COL_KA = 512, COL_VA = 1024, COL_ZA = 1536, COL_QB = 2048, COL_KB = 2560, COL_VB = 2688, COL_ZB = 2816, COL_GA = 3328, COL_GB = 4352;
constexpr float RMS_EPS = 1e-6f;
constexpr float LOG2E = 1.4426950408889634f;
constexpr float C2 = 0.125f * LOG2E;

constexpr size_t MiB = 1u << 20;
constexpr size_t WS_CTL = 0, CTL_ZERO_BYTES = 1 * MiB;
constexpr size_t WS_P = 1 * MiB;
constexpr size_t WS_WP = WS_P + (size_t)MP * NPROJ * 2;
constexpr size_t WS_WO = WS_WP + 2 * MiB;
constexpr size_t WS_TAB = WS_WO + 2 * MiB;
constexpr size_t TAB_RPB = 0, TAB_T5 = 16384, TAB_SINK = 32768;
constexpr size_t WS_END = WS_TAB + 65536;
static_assert(WS_END <= 1073741824ull, "d_ws map exceeds the guaranteed 1 GiB");
constexpr size_t DO_U = 0;
constexpr size_t DO_WIN = 256 * MiB;
static_assert(DO_U + (size_t)MP * DM * 2 <= DO_WIN && DO_WIN + (size_t)NPROJ * DM * 2 <= (size_t)NTOK * DM * 4, "d_out scratch map");
constexpr int CW_TMO = 0, CW_CODE = 1, CW_BAR = 4096;

constexpr int RING_OFF = 0, RING_BYTES = 131072;
constexpr int LDSCTL_OFF = RING_BYTES, MISC_OFF = LDSCTL_OFF + 320;
constexpr int LDS_BYTES = 147456;

#define GAS __attribute__((address_space(1)))
#define LAS __attribute__((address_space(3)))
typedef unsigned short bf16;
typedef unsigned v4u __attribute__((ext_vector_type(4)));
typedef float f32x4 __attribute__((ext_vector_type(4)));
typedef GAS unsigned gu32;
#define RLX_AGENT __ATOMIC_RELAXED, __HIP_MEMORY_SCOPE_AGENT
#define LDS_WAIT() asm volatile("s_waitcnt lgkmcnt(0)" ::: "memory")
#define VM_WAIT() asm volatile("s_waitcnt vmcnt(0)" ::: "memory")
__device__ __forceinline__ unsigned f2bf(float f) { unsigned u = __builtin_bit_cast(unsigned, f); return (u + 0x7fffu + ((u >> 16) & 1u)) >> 16; }
__device__ __forceinline__ unsigned pk2(float lo, float hi) { return f2bf(lo) | (f2bf(hi) << 16); }
__device__ __forceinline__ float bfl(unsigned w) { return __uint_as_float(w << 16); }
__device__ __forceinline__ float bfh(unsigned w) { return __uint_as_float(w & 0xffff0000u); }

#define XB_TMO      128
#define XB_XCNT(j)  (256  + 64 * (j))
#define XB_XSUB(j)  (1280 + 64 * (j))
#define XB_XGEN(j)  (2304 + 64 * (j))
#define XB_TOP      3328
#define XB_TOPGEN   3392
#define XCD_BAR_WORDS 3456
#define XB_SPIN_CAP (1u << 23)
__device__ __forceinline__ unsigned xb_ld(unsigned* p)              { return __hip_atomic_load(p, __ATOMIC_RELAXED, __HIP_MEMORY_SCOPE_AGENT); }
__device__ __forceinline__ unsigned xb_add(unsigned* p, unsigned v) { return __hip_atomic_fetch_add(p, v, __ATOMIC_RELAXED, __HIP_MEMORY_SCOPE_AGENT); }
__device__ __forceinline__ unsigned xb_xcc_id() { return (unsigned)__builtin_amdgcn_s_getreg((3 << 11) | 20) & 0xFu; }
#define XB_SPIN(cond, bar) do { unsigned _sp = 0; while (cond) { __builtin_amdgcn_s_sleep(1); \
    if ((++_sp & 255u) == 0u) { if (xb_ld(&(bar)[XB_TMO])) break; if (_sp > XB_SPIN_CAP) { atomicAdd(&(bar)[XB_TMO], 1u); break; } } } } while (0)
struct XcdBarrier { unsigned* bar; unsigned x; volatile LAS unsigned* st; };
__device__ __forceinline__ XcdBarrier xcd_barrier_post(unsigned* bar, volatile LAS unsigned* st) {
    XcdBarrier b; b.bar = bar; b.x = xb_xcc_id(); b.st = st;
    if (threadIdx.x == 0) (void)xb_add(&bar[XB_XCNT(b.x)], 1u);
    return b;
}
__device__ __forceinline__ void xcd_barrier_complete(unsigned* bar, unsigned x, unsigned& nloc, unsigned& nx) {
    const unsigned G = gridDim.x * gridDim.y * gridDim.z;
    unsigned sum, cnt, mine, sp = 0u;
    for (;;) {
        sum = 0u; cnt = 0u; mine = 0u;
#pragma unroll
        for (unsigned j = 0; j < 16; ++j) { const unsigned c = xb_ld(&bar[XB_XCNT(j)]); sum += c; cnt += (c > 0u) ? 1u : 0u; mine = (j == x) ? c : mine; }
        if (sum == G) break;
        __builtin_amdgcn_s_sleep(1);
        if ((++sp & 255u) == 0u) { if (xb_ld(&bar[XB_TMO])) break; if (sp > XB_SPIN_CAP) { atomicAdd(&bar[XB_TMO], 1u); break; } }
    }
    nloc = mine > 0u ? mine : 1u; nx = cnt > 0u ? cnt : 1u;
}
__device__ __forceinline__ void xcd_barrier(const XcdBarrier& b) {
    asm volatile("s_waitcnt vmcnt(0)" ::: "memory");
    __syncthreads();
    if (threadIdx.x == 0) {
        unsigned* bar = b.bar;
        __builtin_amdgcn_s_waitcnt(0);
        unsigned nloc = b.st[0], nx = b.st[1];
        if (nloc == 0u) { xcd_barrier_complete(bar, b.x, nloc, nx); b.st[0] = nloc; b.st[1] = nx; }
        const unsigned old = xb_add(&bar[XB_XSUB(b.x)], 1u);
        const unsigned gen = old / nloc;
        if (old + 1u == (gen + 1u) * nloc) {
            __builtin_amdgcn_fence(__ATOMIC_RELEASE, "agent");
            asm volatile("s_waitcnt vmcnt(0)" ::: "memory");
            const unsigned og = xb_add(&bar[XB_TOP], 1u);
            const unsigned tg = og / nx;
            if (og + 1u == (tg + 1u) * nx) xb_add(&bar[XB_TOPGEN], 1u);
            else XB_SPIN(xb_ld(&bar[XB_TOPGEN]) == tg, bar);
            __builtin_amdgcn_fence(__ATOMIC_ACQUIRE, "agent");
            xb_add(&bar[XB_XGEN(b.x)], 1u);
            asm volatile("s_waitcnt vmcnt(0)" ::: "memory");
        } else {
            XB_SPIN(xb_ld(&bar[XB_XGEN(b.x)]) == gen, bar);
            __builtin_amdgcn_fence(__ATOMIC_ACQUIRE, "agent");
            asm volatile("s_waitcnt vmcnt(0)" ::: "memory");
        }
    }
    __syncthreads();
}

struct Frame {
    LAS unsigned char* lds;
    volatile LAS unsigned* MISC;
    gu32* ctl;
    int tid, lane, wave;
    int vcu, G;
    const float *xp, *xs, *meta, *norm_g, *w_in, *na_rpb, *sink, *wpa, *wpb, *wout, *t5, *final_g;
    float* out;
    bf16 *P, *WpT, *WoT, *U, *WinT;
    float *rpbL2, *t5L2, *sinkL2;
};

__device__ __forceinline__ float wave_sum(float v) {
#pragma unroll
    for (int o = 1; o < 64; o <<= 1) v += __shfl_xor(v, o);
    return v;
}
__device__ __forceinline__ void p0_transpose_item(const float* W, int K, int N, bf16* WT, int ldt, int row_off, int col_off, const float* gk, float sc, LAS float* scr, int item, int lane) {
    const int nblk = N / 32, kb = item / nblk, nb = item % nblk, k0 = 64 * kb, n0 = 32 * nb;
#pragma unroll 8
    for (int i = 0; i < 32; ++i) { const int kk = 2 * i + (lane >> 5); const float g = gk ? gk[k0 + kk] * sc : sc; scr[kk * 33 + (lane & 31)] = W[(size_t)(k0 + kk) * N + n0 + (lane & 31)] * g; }
    LDS_WAIT(); asm volatile("" ::: "memory");
    const int c = lane & 7;
#pragma unroll
    for (int j = 0; j < 4; ++j) { const int n = (lane >> 3) + 8 * j; const LAS float* s = scr + (8 * c) * 33 + n;
        v4u o; o.x = pk2(s[0 * 33], s[1 * 33]); o.y = pk2(s[2 * 33], s[3 * 33]); o.z = pk2(s[4 * 33], s[5 * 33]); o.w = pk2(s[6 * 33], s[7 * 33]);
        *(GAS v4u*)(WT + (size_t)(row_off + n0 + n) * ldt + col_off + k0 + 8 * c) = o; }
    LDS_WAIT(); asm volatile("" ::: "memory");
}
__device__ __forceinline__ void rms_row_to_bf16(int lane, const float* xrow, bf16* orow) {
    GAS unsigned long long* o8 = (GAS unsigned long long*)orow + lane;
    if (xrow == nullptr) {
#pragma unroll
        for (int j = 0; j < 4; ++j) o8[64 * j] = 0ull;
        return;
    }
    const GAS f32x4* xr = (const GAS f32x4*)xrow + lane;
    f32x4 v[4]; float s = 0.f;
#pragma unroll
    for (int j = 0; j < 4; ++j) { v[j] = xr[64 * j]; s += (v[j].x * v[j].x + v[j].y * v[j].y) + (v[j].z * v[j].z + v[j].w * v[j].w); }
    const float r = 1.0f / sqrtf(wave_sum(s) * (1.f / DM) + RMS_EPS);
#pragma unroll
    for (int j = 0; j < 4; ++j) o8[64 * j] = (unsigned long long)pk2(v[j].x * r, v[j].y * r) | ((unsigned long long)pk2(v[j].z * r, v[j].w * r) << 32);
}
__device__ __forceinline__ int t5_bucket(int rel) {
    const int n = rel < 0 ? -rel : rel; const int base = rel > 0 ? 16 : 0;
    if (n < 8) return base + n;
    int lg = 2 + (31 - __builtin_clz((unsigned)(n * n)));
    return base + (lg < 15 ? lg : 15);
}
__device__ __forceinline__ void p0_prologue(Frame& F) {
    LAS float* scr = (LAS float*)(F.lds + RING_OFF + F.wave * 16384);
    const int gw = F.vcu * NWAVES + F.wave, NGW = F.G * NWAVES;
    constexpr int I_IN = (DM / 64) * (NPROJ / 32), I_PA = (512 / 64) * (DM / 32), I_PB = I_PA, I_O = (DM / 64) * (DM / 32);
    constexpr int NITEMS = I_IN + I_PA + I_PB + I_O;
    for (int it = gw; it < NITEMS; it += NGW) {
        int r = it;
        if (r < I_IN) { const int n0 = 32 * (r % (NPROJ / 32)); const bool isq = (n0 < COL_KA) || (n0 >= COL_QB && n0 < COL_KB);
            p0_transpose_item(F.w_in, DM, NPROJ, F.WinT, DM, 0, 0, F.norm_g, isq ? C2 : 1.0f, scr, r, F.lane); continue; } r -= I_IN;
        if (r < I_PA) { p0_transpose_item(F.wpa, 512, DM, F.WpT, DM, 0, 0, nullptr, 1.0f, scr, r, F.lane); continue; } r -= I_PA;
        if (r < I_PB) { p0_transpose_item(F.wpb, 512, DM, F.WpT, DM, 0, 512, nullptr, 1.0f, scr, r, F.lane); continue; } r -= I_PB;
        p0_transpose_item(F.wout, DM, DM, F.WoT, DM, 0, 0, nullptr, 1.0f, scr, r, F.lane);
    }
    for (int m = gw; m < MP; m += NGW) {
        const float* src = m < N_PROMPT_ROWS ? F.xp + (size_t)m * DM : m < NTOK ? F.xs + (size_t)(m - N_PROMPT_ROWS) * DM : m < NTOK + 16 ? F.meta + (size_t)(m - NTOK) * DM : nullptr;
        rms_row_to_bf16(F.lane, src, F.U + (size_t)m * DM);
    }
    if (blockIdx.x == 0) {
        for (int i = F.tid; i < 8 * 15 * 31; i += NWAVES * 64) F.rpbL2[i] = F.na_rpb[i] * LOG2E;
        for (int i = F.tid; i < 8 * 257; i += NWAVES * 64) { const int h = i / 257, rel = i % 257 - 128; F.t5L2[i] = F.t5[t5_bucket(rel) * 8 + h] * LOG2E; }
        if (F.tid < 8) F.sinkL2[F.tid] = F.sink[F.tid] * LOG2E;
    }
}
__device__ __forceinline__ void p5_final_norm(Frame& F) {
    const int gw = F.vcu * NWAVES + F.wave, NGW = F.G * NWAVES;
    const GAS f32x4* gp = (const GAS f32x4*)F.final_g + F.lane;
    f32x4 gv[4];
#pragma unroll
    for (int j = 0; j < 4; ++j) gv[j] = gp[64 * j];
    for (int m = gw; m < NTOK; m += NGW) {
        GAS f32x4* xr = (GAS f32x4*)(F.out + (size_t)m * DM) + F.lane;
        f32x4 v[4]; float s = 0.f;
#pragma unroll
        for (int j = 0; j < 4; ++j) { v[j] = xr[64 * j]; s += (v[j].x * v[j].x + v[j].y * v[j].y) + (v[j].z * v[j].z + v[j].w * v[j].w); }
        const float r = 1.0f / sqrtf(wave_sum(s) * (1.f / DM) + RMS_EPS);
#pragma unroll
        for (int j = 0; j < 4; ++j) xr[64 * j] = v[j] * r * gv[j];
    }
}
__device__ __forceinline__ void ld64(const bf16* p, float (&f)[64]) {
    const GAS v4u* q = (const GAS v4u*)p;
#pragma unroll
    for (int i = 0; i < 8; ++i) { const v4u w = q[i]; f[8 * i + 0] = bfl(w.x); f[8 * i + 1] = bfh(w.x); f[8 * i + 2] = bfl(w.y); f[8 * i + 3] = bfh(w.y);
        f[8 * i + 4] = bfl(w.z); f[8 * i + 5] = bfh(w.z); f[8 * i + 6] = bfl(w.w); f[8 * i + 7] = bfh(w.w); }
}
__device__ __forceinline__ float dot64(const float (&q)[64], const bf16* kp) {
    const GAS v4u* k4 = (const GAS v4u*)kp; float s0 = 0.f, s1 = 0.f, s2 = 0.f, s3 = 0.f;
#pragma unroll
    for (int i = 0; i < 8; ++i) { const v4u w = k4[i];
        s0 += q[8 * i + 0] * bfl(w.x) + q[8 * i + 1] * bfh(w.x); s1 += q[8 * i + 2] * bfl(w.y) + q[8 * i + 3] * bfh(w.y);
        s2 += q[8 * i + 4] * bfl(w.z) + q[8 * i + 5] * bfh(w.z); s3 += q[8 * i + 6] * bfl(w.w) + q[8 * i + 7] * bfh(w.w); }
    return (s0 + s1) + (s2 + s3);
}
__device__ __forceinline__ void osm_update(float s, const bf16* vp, float& m, float& l, float (&o)[64]) {
    if (s > m) { const float c = __builtin_amdgcn_exp2f(m - s); l *= c;
#pragma unroll
        for (int d = 0; d < 64; ++d) o[d] *= c;
        m = s; }
    const float p = __builtin_amdgcn_exp2f(s - m); l += p;
    const GAS v4u* v4 = (const GAS v4u*)vp;
#pragma unroll
    for (int i = 0; i < 8; ++i) { const v4u w = v4[i];
        o[8 * i + 0] += p * bfl(w.x); o[8 * i + 1] += p * bfh(w.x); o[8 * i + 2] += p * bfl(w.y); o[8 * i + 3] += p * bfh(w.y);
        o[8 * i + 4] += p * bfl(w.z); o[8 * i + 5] += p * bfh(w.z); o[8 * i + 6] += p * bfl(w.w); o[8 * i + 7] += p * bfh(w.w); }
}
__device__ __forceinline__ void finish_gate(bf16* zp, float l, const float (&o)[64]) {
    const float rl = 1.0f / l;
    GAS v4u* z4 = (GAS v4u*)zp;
#pragma unroll
    for (int i = 0; i < 8; ++i) { const v4u w = z4[i]; float z[8] = {bfl(w.x), bfh(w.x), bfl(w.y), bfh(w.y), bfl(w.z), bfh(w.z), bfl(w.w), bfh(w.w)}; float r[8];
#pragma unroll
        for (int e = 0; e < 8; ++e) { const float sg = 1.0f / (1.0f + __builtin_amdgcn_exp2f(-LOG2E * z[e])); r[e] = o[8 * i + e] * rl * z[e] * sg; }
        v4u ov; ov.x = pk2(r[0], r[1]); ov.y = pk2(r[2], r[3]); ov.z = pk2(r[4], r[5]); ov.w = pk2(r[6], r[7]); z4[i] = ov; }
}
__device__ __forceinline__ void batch_of(int t, int& tb, int& n) { if (t < N_PROMPT_ROWS) { tb = t & ~16383; n = 16384; } else { tb = N_PROMPT_ROWS + ((t - N_PROMPT_ROWS) & ~4095); n = 4096; } }

__device__ __forceinline__ void attn_scalar_na(bf16* P, const float* rpbL2, int gtid, int gthreads) {
    for (int id = gtid; id < NTOK * 8; id += gthreads) {
        const int t = id >> 3, h = id & 7; int tb, n; batch_of(t, tb, n);
        const int tl = t - tb, rows = n >> 6, i = tl >> 6, j = tl & 63;
        const int rs = min(max(i - 4, 0), rows - 8), cs = min(max(j - 8, 0), 48);
        float q[64], o[64]; ld64(P + (size_t)t * NPROJ + COL_QA + h * 64, q);
#pragma unroll
        for (int d = 0; d < 64; ++d) o[d] = 0.f;
        float m = -1e30f, l = 0.f;
        for (int a = 0; a < 8; ++a) {
            const float* brow = rpbL2 + (h * 15 + (rs + a - i + 7)) * 31 + (cs - j + 15);
            const bf16* krow = P + (size_t)(tb + (rs + a) * 64 + cs) * NPROJ + h * 64;
            for (int c = 0; c < 16; ++c) { const bf16* kr = krow + (size_t)c * NPROJ;
                const float s = dot64(q, kr + COL_KA) + brow[c]; osm_update(s, kr + COL_VA, m, l, o); }
        }
        for (int mm = 0; mm < 16; ++mm) { const bf16* kr = P + (size_t)(META_ROW + mm) * NPROJ + h * 64;
            const float s = dot64(q, kr + COL_KA); osm_update(s, kr + COL_VA, m, l, o); }
        finish_gate(P + (size_t)t * NPROJ + COL_ZA + h * 64, l, o);
    }
}
__device__ __forceinline__ void attn_scalar_wa(bf16* P, const float* t5L2, const float* sinkL2, int gtid, int gthreads) {
    for (int id = gtid; id < NTOK * 8; id += gthreads) {
        const int t = id >> 3, h = id & 7, kh = h >> 2; int tb, n; batch_of(t, tb, n);
        const int tl = t - tb;
        float q[64], o[64]; ld64(P + (size_t)t * NPROJ + COL_QB + h * 64, q);
#pragma unroll
        for (int d = 0; d < 64; ++d) o[d] = 0.f;
        float m = -1e30f, l = 0.f;
        const int s0 = max(tl - 128, 0), s1 = min(tl + 128, n - 1);
        const float* tb5 = t5L2 + h * 257;
        for (int s = s0; s <= s1; ++s) { const bf16* kr = P + (size_t)(tb + s) * NPROJ + kh * 64;
            const float sc = dot64(q, kr + COL_KB) + tb5[s - tl + 128]; osm_update(sc, kr + COL_VB, m, l, o); }
        for (int mm = 0; mm < 16; ++mm) { const bf16* kr = P + (size_t)(META_ROW + mm) * NPROJ + kh * 64;
            const int nn = min(tl + 16 - mm, 128);
            const float sc = dot64(q, kr + COL_KB) + tb5[128 - nn]; osm_update(sc, kr + COL_VB, m, l, o); }
        { const float sk = sinkL2[h]; if (sk > m) { const float c = __builtin_amdgcn_exp2f(m - sk); l *= c;
#pragma unroll
              for (int d = 0; d < 64; ++d) o[d] *= c;
              m = sk; }
          l += __builtin_amdgcn_exp2f(sk - m); }
        finish_gate(P + (size_t)t * NPROJ + COL_ZB + h * 64, l, o);
    }
}
struct Args { const float* in[12]; float* out; unsigned char* ws; int ph_lo, ph_hi, li, pad; };
__global__ void __launch_bounds__(NWAVES * 64, 2) mk_fwd(Args args) {
    extern __shared__ __attribute__((aligned(16))) unsigned char lds[];
    Frame F;
    F.lds = (LAS unsigned char*)lds;
    F.MISC = (volatile LAS unsigned*)(F.lds + MISC_OFF);
    F.tid = threadIdx.x; F.lane = F.tid & 63; F.wave = __builtin_amdgcn_readfirstlane(F.tid >> 6);
    F.G = gridDim.x; { const int bx = blockIdx.x; F.vcu = (F.G % 8 == 0) ? (bx % 8) * (F.G / 8) + bx / 8 : bx; }
    unsigned char* ws = args.ws;
    F.ctl = (gu32*)(ws + WS_CTL);
    F.xp = args.in[0]; F.xs = args.in[1]; F.meta = args.in[2]; F.norm_g = args.in[3]; F.w_in = args.in[4]; F.na_rpb = args.in[5]; F.sink = args.in[6];
    F.wpa = args.in[7]; F.wpb = args.in[8]; F.wout = args.in[9]; F.t5 = args.in[10]; F.final_g = args.in[11]; F.out = args.out;
    F.P = (bf16*)(ws + WS_P); F.WpT = (bf16*)(ws + WS_WP); F.WoT = (bf16*)(ws + WS_WO);
    F.U = (bf16*)((unsigned char*)args.out + DO_U); F.WinT = (bf16*)((unsigned char*)args.out + DO_WIN);
    F.rpbL2 = (float*)(ws + WS_TAB + TAB_RPB); F.t5L2 = (float*)(ws + WS_TAB + TAB_T5); F.sinkL2 = (float*)(ws + WS_TAB + TAB_SINK);
    for (int u = F.tid; u < (LDS_BYTES - LDSCTL_OFF) / 4; u += NWAVES * 64) ((LAS unsigned*)(F.lds + LDSCTL_OFF))[u] = 0u;
    __syncthreads();
    XcdBarrier bar; bar.bar = (unsigned*)(F.ctl + CW_BAR); bar.x = 0; bar.st = nullptr;
    if (N_LAUNCHES != PER_PHASE) bar = xcd_barrier_post((unsigned*)(F.ctl + CW_BAR), F.MISC + 8);
#define GRID_BAR() do { if (N_LAUNCHES != PER_PHASE) xcd_barrier(bar); } while (0)
    const int lo = args.ph_lo, hi = args.ph_hi;
#define IN(k) (lo <= (k) && (k) < hi)
#define BOTH(k) (IN(k) && IN((k) + 1))
    if (IN(0)) { p0_prologue(F); if (BOTH(0)) GRID_BAR(); }
    if (IN(1)) {
        pg8::Gemm g{F.U, F.WinT, MP, NPROJ, DM, DM, DM}; pg8::StaticOrder S; S.init(MP, NPROJ, F.G, (int)blockIdx.x);
        pg8::EpiStoreBf16 E{F.P, NPROJ};
        pg8::gemm_phase<pg8::EpiStoreBf16, pg8::StaticOrder, PG8_ALIGN, PG8_SP2>(F.lds + RING_OFF, g, S, E);
        if (BOTH(1)) GRID_BAR();
    }
    if (IN(2)) {
        const int gtid = F.vcu * (NWAVES * 64) + F.tid, gthreads = F.G * NWAVES * 64;
        attn_scalar_na(F.P, F.rpbL2, gtid, gthreads);
        attn_scalar_wa(F.P, F.t5L2, F.sinkL2, gtid, gthreads);
        if (BOTH(2)) GRID_BAR();
    }
    if (IN(3)) {
        { pg8::Gemm g{F.P + COL_ZA, F.WpT, NTOK, DM, 512, NPROJ, DM}; pg8::StaticOrder S; S.init(NTOK, DM, F.G, (int)blockIdx.x);
          pg8::EpiGate<false> E{F.P, NPROJ, COL_GA};
          pg8::gemm_phase<pg8::EpiGate<false>, pg8::StaticOrder, PG8_ALIGN, PG8_SP2>(F.lds + RING_OFF, g, S, E); }
        { pg8::Gemm g{F.P + COL_ZB, F.WpT + 512, NTOK, DM, 512, NPROJ, DM}; pg8::StaticOrder S; S.init(NTOK, DM, F.G, (int)blockIdx.x);
          pg8::EpiGate<true> E{F.P, NPROJ, COL_GB};
          pg8::gemm_phase<pg8::EpiGate<true>, pg8::StaticOrder, PG8_ALIGN, PG8_SP2>(F.lds + RING_OFF, g, S, E); }
        if (BOTH(3)) GRID_BAR();
    }
    if (IN(4)) {
        pg8::Gemm g{F.P, F.WoT, NTOK, DM, DM, NPROJ, DM}; pg8::StaticOrder S; S.init(NTOK, DM, F.G, (int)blockIdx.x);
        pg8::EpiResF32 E{F.xp, F.xs, N_PROMPT_ROWS, F.out, DM};
        pg8::gemm_phase<pg8::EpiResF32, pg8::StaticOrder, PG8_ALIGN, PG8_SP2>(F.lds + RING_OFF, g, S, E);
        if (BOTH(4)) GRID_BAR();
    }
    if (IN(5)) { p5_final_norm(F); }
#undef IN
#undef BOTH
}

extern "C" void kernel_launch(void* const* d_in, const int* in_sizes, int n_in, void* d_out, int out_size, void* d_ws, size_t ws_size, hipStream_t stream) {
    static int grid = 0;
    if (grid == 0) {
        if (n_in != 12 || out_size != NTOK * DM || ws_size < WS_END) { fprintf(stderr, "kernel_launch: unexpected shapes: n_in %d out %d ws %zu (need %zu)\n", n_in, out_size, ws_size, (size_t)WS_END); grid = -1; return; }
        int dev = 0, cus = 0;
        if (hipGetDevice(&dev) != hipSuccess || hipDeviceGetAttribute(&cus, hipDeviceAttributeMultiprocessorCount, dev) != hipSuccess) { grid = -1; return; }
        if (hipFuncSetAttribute((const void*)mk_fwd, hipFuncAttributeMaxDynamicSharedMemorySize, LDS_BYTES) != hipSuccess) { fprintf(stderr, "kernel_launch: hipFuncSetAttribute failed\n"); grid = -1; return; }
        (void)hipGetLastError();
        grid = cus;
    }
    if (grid < 0) return;
    (void)hipMemsetAsync((char*)d_ws + WS_CTL, 0, CTL_ZERO_BYTES, stream);
    Args a{};
    for (int i = 0; i < 12; ++i) a.in[i] = (const float*)d_in[i];
    a.out = (float*)d_out; a.ws = (unsigned char*)d_ws;
    for (int li = 0; li < N_LAUNCHES; ++li) {
        a.ph_lo = (N_LAUNCHES == PER_PHASE) ? li : 0; a.ph_hi = (N_LAUNCHES == PER_PHASE) ? li + 1 : PER_PHASE; a.li = li;
        hipLaunchKernelGGL(mk_fwd, dim3(grid), dim3(NWAVES * 64), LDS_BYTES, stream, a);
    }
}
```

```cpp
#define MK_N_LAUNCHES 1
#include <hip/hip_runtime.h>
#include <cstdio>
#include <cstdint>
namespace pg8 {
#define PG8_LAS __attribute__((address_space(3)))
typedef unsigned short bf16_t;
typedef short bf16x8 __attribute__((ext_vector_type(8)));
typedef float f32x4 __attribute__((ext_vector_type(4)));
typedef unsigned u32x4 __attribute__((ext_vector_type(4)));
constexpr int BM = 256, BK = 64, HALF = 128, HTB = HALF * BK * 2  , STAGE_BYTES = 8 * HTB, NXCD = 8, WGM = 8;

__host__ __device__ __forceinline__ int lds_byte(int r, int c) { const int st = (r >> 4) * 2 + (c >> 5), rr = r & 15, cc = c & 31, ob = rr * 64 + cc * 2; return st * 1024 + (ob ^ (((ob >> 9) & 1) << 5)); }
__host__ __device__ __forceinline__ void stage_rc(int b, int& R, int& C) { const int st = b / 1024, sb = b % 1024, swz = sb ^ (((sb >> 9) & 1) << 5); R = (st >> 1) * 16 + swz / 64; C = (st & 1) * 32 + (swz % 64) / 2; }
__host__ __device__ __forceinline__ int perm32(int rho) { const int n = rho >> 4, i = rho & 15; return 8 * (i >> 2) + 4 * n + (i & 3); }

struct Unit { int pm, pn; };
struct Gemm { const bf16_t* A; const bf16_t* Bt; int M, N, K, lda, ldb; };

struct StaticOrder {
    int nM, nN, nwg, G, c;
    __host__ __device__ void init(int M, int N, int G_, int c_) { nM = M / BM; nN = N / BM; nwg = nM * nN; G = G_; c = c_; }
    __host__ __device__ bool next(int i, Unit& u) const {
        const long L = (long)i * G + c; if (L >= nwg) return false;
        int wgid = (int)L; { const int q = nwg / NXCD, r = nwg % NXCD, xcd = wgid % NXCD, off = wgid / NXCD; wgid = (xcd < r ? xcd * (q + 1) : r * (q + 1) + (xcd - r) * q) + off; }
        const int nig = WGM * nN, gid = wgid / nig, fm = gid * WGM, gsz = (nM - fm) < WGM ? (nM - fm) : WGM;
        u.pm = fm + ((wgid % nig) % gsz); u.pn = (wgid % nig) / gsz; return true;
    }
    __device__ __forceinline__ void a_ready(const Unit&) const {}
    __device__ __forceinline__ void done(const Unit&) const {}
};

__device__ __forceinline__ unsigned cvt_pk_bf16(float lo, float hi) { unsigned r; asm volatile("v_cvt_pk_bf16_f32 %0, %1, %2" : "=v"(r) : "v"(lo), "v"(hi)); return r; }
__device__ __forceinline__ float bf_lo(unsigned w) { return __uint_as_float(w << 16); }
__device__ __forceinline__ float bf_hi(unsigned w) { return __uint_as_float(w & 0xffff0000u); }
__device__ __forceinline__ float sigmoidf_fast(float g) { return __builtin_amdgcn_rcpf(1.0f + __builtin_amdgcn_exp2f(-1.4426950408889634f * g)); }
struct EpiStoreBf16 {
    static constexpr bool PERM = true, AFTER_DRAIN = false;
    bf16_t* O; int ldc;
    __device__ __forceinline__ void operator()(const f32x4 (&acc)[2][2][4][2], const Unit& u, int wr, int wc, int fr, int fq) const {
        const int row0 = u.pm * BM + wr * 64 + fr; const int col0 = u.pn * BM + wc * 32 + 8 * fq;
#pragma unroll
        for (int ai = 0; ai < 2; ++ai)
#pragma unroll
            for (int m = 0; m < 4; ++m) { bf16_t* rowp = O + (size_t)(row0 + ai * HALF + m * 16) * ldc + col0;
#pragma unroll
                for (int bj = 0; bj < 2; ++bj) { const f32x4 v0 = acc[ai][bj][m][0], v1 = acc[ai][bj][m][1];
                    u32x4 w; w.x = cvt_pk_bf16(v0[0], v0[1]); w.y = cvt_pk_bf16(v0[2], v0[3]); w.z = cvt_pk_bf16(v1[0], v1[1]); w.w = cvt_pk_bf16(v1[2], v1[3]);
                    *(u32x4*)(rowp + bj * HALF) = w; } }
    }
};
template <bool ADD> struct EpiGate {
    static constexpr bool PERM = true, AFTER_DRAIN = false;
    bf16_t* P; int ldc; int gate_col;
    __device__ __forceinline__ void operator()(const f32x4 (&acc)[2][2][4][2], const Unit& u, int wr, int wc, int fr, int fq) const {
        const int row0 = u.pm * BM + wr * 64 + fr; const int col0 = u.pn * BM + wc * 32 + 8 * fq;
#pragma unroll
        for (int ai = 0; ai < 2; ++ai)
#pragma unroll
            for (int m = 0; m < 4; ++m) { bf16_t* rowp = P + (size_t)(row0 + ai * HALF + m * 16) * ldc + col0;
#pragma unroll
                for (int bj = 0; bj < 2; ++bj) { const f32x4 v0 = acc[ai][bj][m][0], v1 = acc[ai][bj][m][1];
                    const u32x4 gw = *(const u32x4*)(rowp + gate_col + bj * HALF);
                    float r[8];
                    r[0] = v0[0] * sigmoidf_fast(bf_lo(gw.x)); r[1] = v0[1] * sigmoidf_fast(bf_hi(gw.x));
                    r[2] = v0[2] * sigmoidf_fast(bf_lo(gw.y)); r[3] = v0[3] * sigmoidf_fast(bf_hi(gw.y));
                    r[4] = v1[0] * sigmoidf_fast(bf_lo(gw.z)); r[5] = v1[1] * sigmoidf_fast(bf_hi(gw.z));
                    r[6] = v1[2] * sigmoidf_fast(bf_lo(gw.w)); r[7] = v1[3] * sigmoidf_fast(bf_hi(gw.w));
                    if (ADD) { const u32x4 pw = *(const u32x4*)(rowp + bj * HALF);
                        r[0] += bf_lo(pw.x); r[1] += bf_hi(pw.x); r[2] += bf_lo(pw.y); r[3] += bf_hi(pw.y);
                        r[4] += bf_lo(pw.z); r[5] += bf_hi(pw.z); r[6] += bf_lo(pw.w); r[7] += bf_hi(pw.w); }
                    u32x4 w; w.x = cvt_pk_bf16(r[0], r[1]); w.y = cvt_pk_bf16(r[2], r[3]); w.z = cvt_pk_bf16(r[4], r[5]); w.w = cvt_pk_bf16(r[6], r[7]);
                    *(u32x4*)(rowp + bj * HALF) = w; } }
    }
};
struct EpiResF32 {
    static constexpr bool PERM = false, AFTER_DRAIN = false;
    const float* xa; const float* xb; int nsplit; float* out; int ldc;
    __device__ __forceinline__ void operator()(const f32x4 (&acc)[2][2][4][2], const Unit& u, int wr, int wc, int fr, int fq) const {
        const int row0 = u.pm * BM + wr * 64 + fr, col0 = u.pn * BM + wc * 32 + 4 * fq;
#pragma unroll
        for (int ai = 0; ai < 2; ++ai)
#pragma unroll
            for (int m = 0; m < 4; ++m) { const int row = row0 + ai * HALF + m * 16;
                const float* xr = (row < nsplit ? xa + (size_t)row * ldc : xb + (size_t)(row - nsplit) * ldc) + col0;
                float* rowp = out + (size_t)row * ldc + col0;
#pragma unroll
                for (int bj = 0; bj < 2; ++bj)
#pragma unroll
                    for (int n = 0; n < 2; ++n) *(f32x4*)(rowp + bj * HALF + n * 16) = acc[ai][bj][m][n] + *(const f32x4*)(xr + bj * HALF + n * 16); }
    }
};
template <class Epi, class Sched, bool ALIGN_EPI = false, bool SP2 = false>
__device__ __forceinline__ void gemm_phase(PG8_LAS unsigned char* lds, const Gemm g, const Sched& S, const Epi& E) {
    const int tid = threadIdx.x, wid = __builtin_amdgcn_readfirstlane(tid >> 6), lane = tid & 63, wr = wid >> 2, wc = wid & 3, fr = lane & 15, fq = lane >> 4;
    const int K = g.K, nt = K / BK;
    unsigned voffA[2], voffB[2];
#pragma unroll
    for (int i = 0; i < 2; ++i) { int R, C; stage_rc(tid * 16 + i * 8192, R, C); const int Rb = Epi::PERM ? ((R & ~31) + perm32(R & 31)) : R;
        voffA[i] = (unsigned)(R * g.lda + C) * 2u; voffB[i] = (unsigned)(Rb * g.ldb + C) * 2u; }
    const size_t kstep = (size_t)(BK * 2);
    const size_t hstepA = (size_t)HALF * g.lda * 2, hstepB = (size_t)HALF * g.ldb * 2;
    const size_t tstepA = 2 * hstepA, tstepB = 2 * hstepB;
    const unsigned ldsw = (unsigned)wid * 1024u;
    const int aoff = lds_byte(wr * 64 + fr, fq * 8), boff = lds_byte(wc * 32 + fr, fq * 8);
#define PG8_SA(b, h) (((b) * 2 + (h)) * HTB)
#define PG8_SB(b, h) ((4 + (b) * 2 + (h)) * HTB)
#define PG8_STAGE(bufoff, gbase, voff) do { _Pragma("unroll") for (int _i = 0; _i < 2; ++_i) \
        __builtin_amdgcn_global_load_lds((const unsigned*)((const char*)(gbase) + (voff)[_i]), (PG8_LAS unsigned*)(lds + (bufoff) + ldsw + _i * 8192), 16, 0, 0); } while (0)
#define PG8_LDA(dst, b, h) do { _Pragma("unroll") for (int m = 0; m < 4; ++m) _Pragma("unroll") for (int k = 0; k < 2; ++k) dst[m][k] = *(const PG8_LAS bf16x8*)(lds + PG8_SA(b, h) + aoff + m * 2048 + k * 1024); } while (0)
#define PG8_LDB(dst, b, h) do { _Pragma("unroll") for (int n = 0; n < 2; ++n) _Pragma("unroll") for (int k = 0; k < 2; ++k) dst[n][k] = *(const PG8_LAS bf16x8*)(lds + PG8_SB(b, h) + boff + n * 2048 + k * 1024); } while (0)
#define PG8_MMA(ai, bj, At, Bt) do { __builtin_amdgcn_s_setprio(1); _Pragma("unroll") for (int m = 0; m < 4; ++m) _Pragma("unroll") for (int n = 0; n < 2; ++n) _Pragma("unroll") for (int k = 0; k < 2; ++k) \
        acc[ai][bj][m][n] = __builtin_amdgcn_mfma_f32_16x16x32_bf16(Bt[n][k], At[m][k], acc[ai][bj][m][n], 0, 0, 0); __builtin_amdgcn_s_setprio(0); } while (0)
#define PG8_WAIT_V(n) asm volatile("s_waitcnt vmcnt(" #n ")" ::: "memory")
#define PG8_WAIT_L(n) asm volatile("s_waitcnt lgkmcnt(" #n ")" ::: "memory")
#define PG8_BAR __builtin_amdgcn_s_barrier()
#define PG8_SCHED __builtin_amdgcn_sched_barrier(0)
    Unit cur, nxt; int ui = 0;
    if (!S.next(0, cur)) return;
    f32x4 acc[2][2][4][2];
#pragma unroll
    for (int a = 0; a < 2; ++a)
#pragma unroll
        for (int b = 0; b < 2; ++b)
#pragma unroll
            for (int m = 0; m < 4; ++m)
#pragma unroll
                for (int n = 0; n < 2; ++n) acc[a][b][m][n] = (f32x4){0.f, 0.f, 0.f, 0.f};
    bf16x8 At[4][2], B0[2][2], B1[2][2];
    const char* cA = (const char*)g.A + (size_t)cur.pm * tstepA; const char* cB = (const char*)g.Bt + (size_t)cur.pn * tstepB;
    S.a_ready(cur);
    if constexpr (SP2) {
        PG8_STAGE(PG8_SB(0, 0), cB, voffB); PG8_STAGE(PG8_SB(0, 1), cB + hstepB, voffB); PG8_STAGE(PG8_SA(0, 0), cA, voffA); PG8_STAGE(PG8_SA(0, 1), cA + hstepA, voffA);
        if (wr == 1) PG8_BAR;
        PG8_WAIT_V(2); PG8_BAR;
        PG8_STAGE(PG8_SB(1, 0), cB + kstep, voffB); PG8_STAGE(PG8_SA(1, 0), cA + kstep, voffA); PG8_STAGE(PG8_SB(1, 1), cB + hstepB + kstep, voffB);
        PG8_WAIT_V(6); PG8_BAR;
    } else {
        PG8_STAGE(PG8_SB(0, 0), cB, voffB); PG8_STAGE(PG8_SA(0, 0), cA, voffA); PG8_STAGE(PG8_SB(0, 1), cB + hstepB, voffB); PG8_STAGE(PG8_SA(0, 1), cA + hstepA, voffA);
        if (wr == 1) PG8_BAR;
        PG8_WAIT_V(4); PG8_BAR;
        PG8_STAGE(PG8_SB(1, 0), cB + kstep, voffB); PG8_STAGE(PG8_SA(1, 0), cA + kstep, voffA); PG8_STAGE(PG8_SB(1, 1), cB + hstepB + kstep, voffB);
        PG8_WAIT_V(6); PG8_BAR;
    }
    for (;;) {
        const bool has_next = S.next(ui + 1, nxt);
        const char* nA = has_next ? (const char*)g.A + (size_t)nxt.pm * tstepA : cA; const char* nB = has_next ? (const char*)g.Bt + (size_t)nxt.pn * tstepB : cB;
        for (int t = 0; t < nt; t += 2) {
            const bool last = (t == nt - 2);
            const char* a1 = cA + (size_t)(t + 1) * kstep;
            const char* a2 = last ? nA : cA + (size_t)(t + 2) * kstep; const char* b2 = last ? nB : cB + (size_t)(t + 2) * kstep;
            const char* a3 = a2 + kstep; const char* b3 = b2 + kstep;
            if (last && has_next) S.a_ready(nxt);
            if constexpr (SP2) {
            PG8_LDB(B0, 0, 0); PG8_LDB(B1, 0, 1); PG8_SCHED; PG8_LDA(At, 0, 0); PG8_STAGE(PG8_SA(1, 1), a1 + hstepA, voffA);
            PG8_WAIT_V(8); PG8_WAIT_L(0); PG8_BAR; PG8_MMA(0, 0, At, B0); PG8_MMA(0, 1, At, B1); PG8_BAR; PG8_SCHED;
            PG8_LDA(At, 0, 1); PG8_STAGE(PG8_SB(0, 0), b2, voffB); PG8_STAGE(PG8_SB(0, 1), b2 + hstepB, voffB); PG8_STAGE(PG8_SA(0, 0), a2, voffA);
            PG8_WAIT_V(8); PG8_WAIT_L(0); PG8_BAR; PG8_MMA(1, 0, At, B0); PG8_MMA(1, 1, At, B1); PG8_BAR; PG8_SCHED;
            PG8_LDB(B0, 1, 0); PG8_LDB(B1, 1, 1); PG8_SCHED; PG8_LDA(At, 1, 0); PG8_STAGE(PG8_SA(0, 1), a2 + hstepA, voffA);
            PG8_WAIT_V(8); PG8_WAIT_L(0); PG8_BAR; PG8_MMA(0, 0, At, B0); PG8_MMA(0, 1, At, B1); PG8_BAR; PG8_SCHED;
            PG8_LDA(At, 1, 1); PG8_STAGE(PG8_SB(1, 0), b3, voffB); PG8_STAGE(PG8_SB(1, 1), b3 + hstepB, voffB); PG8_STAGE(PG8_SA(1, 0), a3, voffA);
            PG8_WAIT_V(8); PG8_WAIT_L(0); PG8_BAR; PG8_MMA(1, 0, At, B0); PG8_MMA(1, 1, At, B1); PG8_BAR; PG8_SCHED;
            } else {
            PG8_LDB(B0, 0, 0); PG8_SCHED; PG8_LDA(At, 0, 0); PG8_STAGE(PG8_SA(1, 1), a1 + hstepA, voffA);
            PG8_WAIT_L(8); PG8_BAR; PG8_WAIT_L(0); PG8_MMA(0, 0, At, B0); PG8_BAR; PG8_SCHED;
            PG8_LDB(B1, 0, 1); PG8_STAGE(PG8_SB(0, 0), b2, voffB);
            PG8_BAR; PG8_WAIT_L(0); PG8_MMA(0, 1, At, B1); PG8_BAR;
            PG8_LDA(At, 0, 1); PG8_STAGE(PG8_SA(0, 0), a2, voffA);
            PG8_BAR; PG8_WAIT_L(0); PG8_MMA(1, 0, At, B0); PG8_BAR; PG8_SCHED;
            PG8_STAGE(PG8_SB(0, 1), b2 + hstepB, voffB);
            PG8_WAIT_V(6); PG8_BAR; PG8_MMA(1, 1, At, B1); PG8_BAR;
            PG8_LDB(B0, 1, 0); PG8_SCHED; PG8_LDA(At, 1, 0); PG8_STAGE(PG8_SA(0, 1), a2 + hstepA, voffA);
            PG8_WAIT_L(8); PG8_BAR; PG8_WAIT_L(0); PG8_MMA(0, 0, At, B0); PG8_BAR; PG8_SCHED;
            PG8_LDB(B1, 1, 1); PG8_STAGE(PG8_SB(1, 0), b3, voffB);
            PG8_BAR; PG8_WAIT_L(0); PG8_MMA(0, 1, At, B1); PG8_BAR;
            PG8_LDA(At, 1, 1); PG8_STAGE(PG8_SA(1, 0), a3, voffA);
            PG8_BAR; PG8_WAIT_L(0); PG8_MMA(1, 0, At, B0); PG8_BAR; PG8_SCHED;
            PG8_STAGE(PG8_SB(1, 1), b3 + hstepB, voffB);
            PG8_WAIT_V(6); PG8_BAR; PG8_MMA(1, 1, At, B1); PG8_BAR;
            }
        }
        if constexpr (ALIGN_EPI) { if (wr == 0) PG8_BAR; }
        if constexpr (!Epi::AFTER_DRAIN) { E(acc, cur, wr, wc, fr, fq); S.done(cur); }
        if (!has_next) break;
#pragma unroll
        for (int a = 0; a < 2; ++a)
#pragma unroll
            for (int b = 0; b < 2; ++b)
#pragma unroll
                for (int m = 0; m < 4; ++m)
#pragma unroll
                    for (int n = 0; n < 2; ++n) acc[a][b][m][n] = (f32x4){0.f, 0.f, 0.f, 0.f};
        cur = nxt; cA = nA; cB = nB; ++ui;
        if constexpr (ALIGN_EPI) { if (wr == 1) PG8_BAR; }
    }
    PG8_WAIT_V(0);
    if constexpr (!ALIGN_EPI) { if (wr == 0) PG8_BAR; }
    PG8_BAR;
    if constexpr (Epi::AFTER_DRAIN) { E.fused(acc, cur, wr, wc, fr, fq, lds, wid, lane); S.done(cur); }
#undef PG8_SA
#undef PG8_SB
#undef PG8_STAGE
#undef PG8_LDA
#undef PG8_LDB
#undef PG8_MMA
#undef PG8_WAIT_V
#undef PG8_WAIT_L
#undef PG8_BAR
#undef PG8_SCHED
}
}

#ifndef PG8_SP2
#define PG8_SP2 true
#endif
#ifndef PG8_ALIGN
#define PG8_ALIGN true
#endif

constexpr int NWAVES = 8;
#ifndef MK_N_LAUNCHES
#define MK_N_LAUNCHES 1
#endif
constexpr int N_LAUNCHES = MK_N_LAUNCHES;
constexpr int PER_PHASE = 6;

constexpr int DM = 1024, NTOK = 98304, MP = 98560, NPROJ = 5376, N_PROMPT_ROWS = 32768, META_ROW = 98304;
constexpr int COL_QA = 0, COL_KA = 512, COL_VA = 1024, COL_ZA = 1536, COL_QB = 2048, COL_KB = 2560, COL_VB = 2688, COL_ZB = 2816, COL_GA = 3328, COL_GB = 4352;
constexpr float RMS_EPS = 1e-6f;
constexpr float LOG2E = 1.4426950408889634f;
constexpr float C2 = 0.125f * LOG2E;

constexpr size_t MiB = 1u << 20;
constexpr size_t WS_CTL = 0, CTL_ZERO_BYTES = 1 * MiB;
constexpr size_t WS_P = 1 * MiB;
constexpr size_t WS_WP = WS_P + (size_t)MP * NPROJ * 2;
constexpr size_t WS_WO = WS_WP + 2 * MiB;
constexpr size_t WS_TAB = WS_WO + 2 * MiB;
constexpr size_t TAB_RPB = 0, TAB_T5 = 16384, TAB_SINK = 32768;
constexpr size_t WS_END = WS_TAB + 65536;
static_assert(WS_END <= 1073741824ull, "d_ws map exceeds the guaranteed 1 GiB");
constexpr size_t DO_U = 0;
constexpr size_t DO_WIN = 256 * MiB;
static_assert(DO_U + (size_t)MP * DM * 2 <= DO_WIN && DO_WIN + (size_t)NPROJ * DM * 2 <= (size_t)NTOK * DM * 4, "d_out scratch map");
constexpr int CW_TMO = 0, CW_CODE = 1, CW_BAR = 4096;

constexpr int RING_OFF = 0, RING_BYTES = 131072;
constexpr int LDSCTL_OFF = RING_BYTES, MISC_OFF = LDSCTL_OFF + 320;
constexpr int LDS_BYTES = 147456;

#define GAS __attribute__((address_space(1)))
#define LAS __attribute__((address_space(3)))
typedef unsigned short bf16;
typedef unsigned v4u __attribute__((ext_vector_type(4)));
typedef float f32x4 __attribute__((ext_vector_type(4)));
typedef GAS unsigned gu32;
#define RLX_AGENT __ATOMIC_RELAXED, __HIP_MEMORY_SCOPE_AGENT
#define LDS_WAIT() asm volatile("s_waitcnt lgkmcnt(0)" ::: "memory")
#define VM_WAIT() asm volatile("s_waitcnt vmcnt(0)" ::: "memory")
__device__ __forceinline__ unsigned f2bf(float f) { unsigned u = __builtin_bit_cast(unsigned, f); return (u + 0x7fffu + ((u >> 16) & 1u)) >> 16; }
__device__ __forceinline__ unsigned pk2(float lo, float hi) { return f2bf(lo) | (f2bf(hi) << 16); }
__device__ __forceinline__ float bfl(unsigned w) { return __uint_as_float(w << 16); }
__device__ __forceinline__ float bfh(unsigned w) { return __uint_as_float(w & 0xffff0000u); }

#define XB_TMO      128
#define XB_XCNT(j)  (256  + 64 * (j))
#define XB_XSUB(j)  (1280 + 64 * (j))
#define XB_XGEN(j)  (2304 + 64 * (j))
#define XB_TOP      3328
#define XB_TOPGEN   3392
#define XCD_BAR_WORDS 3456
#define XB_SPIN_CAP (1u << 23)
__device__ __forceinline__ unsigned xb_ld(unsigned* p)              { return __hip_atomic_load(p, __ATOMIC_RELAXED, __HIP_MEMORY_SCOPE_AGENT); }
__device__ __forceinline__ unsigned xb_add(unsigned* p, unsigned v) { return __hip_atomic_fetch_add(p, v, __ATOMIC_RELAXED, __HIP_MEMORY_SCOPE_AGENT); }
__device__ __forceinline__ unsigned xb_xcc_id() { return (unsigned)__builtin_amdgcn_s_getreg((3 << 11) | 20) & 0xFu; }
#define XB_SPIN(cond, bar) do { unsigned _sp = 0; while (cond) { __builtin_amdgcn_s_sleep(1); \
    if ((++_sp & 255u) == 0u) { if (xb_ld(&(bar)[XB_TMO])) break; if (_sp > XB_SPIN_CAP) { atomicAdd(&(bar)[XB_TMO], 1u); break; } } } } while (0)
struct XcdBarrier { unsigned* bar; unsigned x; volatile LAS unsigned* st; };
__device__ __forceinline__ XcdBarrier xcd_barrier_post(unsigned* bar, volatile LAS unsigned* st) {
    XcdBarrier b; b.bar = bar; b.x = xb_xcc_id(); b.st = st;
    if (threadIdx.x == 0) (void)xb_add(&bar[XB_XCNT(b.x)], 1u);
    return b;
}
__device__ __forceinline__ void xcd_barrier_complete(unsigned* bar, unsigned x, unsigned& nloc, unsigned& nx) {
    const unsigned G = gridDim.x * gridDim.y * gridDim.z;
    unsigned sum, cnt, mine, sp = 0u;
    for (;;) {
        sum = 0u; cnt = 0u; mine = 0u;
#pragma unroll
        for (unsigned j = 0; j < 16; ++j) { const unsigned c = xb_ld(&bar[XB_XCNT(j)]); sum += c; cnt += (c > 0u) ? 1u : 0u; mine = (j == x) ? c : mine; }
        if (sum == G) break;
        __builtin_amdgcn_s_sleep(1);
        if ((++sp & 255u) == 0u) { if (xb_ld(&bar[XB_TMO])) break; if (sp > XB_SPIN_CAP) { atomicAdd(&bar[XB_TMO], 1u); break; } }
    }
    nloc = mine > 0u ? mine : 1u; nx = cnt > 0u ? cnt : 1u;
}
__device__ __forceinline__ void xcd_barrier(const XcdBarrier& b) {
    asm volatile("s_waitcnt vmcnt(0)" ::: "memory");
    __syncthreads();
    if (threadIdx.x == 0) {
        unsigned* bar = b.bar;
        __builtin_amdgcn_s_waitcnt(0);
        unsigned nloc = b.st[0], nx = b.st[1];
        if (nloc == 0u) { xcd_barrier_complete(bar, b.x, nloc, nx); b.st[0] = nloc; b.st[1] = nx; }
        const unsigned old = xb_add(&bar[XB_XSUB(b.x)], 1u);
        const unsigned gen = old / nloc;
        if (old + 1u == (gen + 1u) * nloc) {
            __builtin_amdgcn_fence(__ATOMIC_RELEASE, "agent");
            asm volatile("s_waitcnt vmcnt(0)" ::: "memory");
            const unsigned og = xb_add(&bar[XB_TOP], 1u);
            const unsigned tg = og / nx;
            if (og + 1u == (tg + 1u) * nx) xb_add(&bar[XB_TOPGEN], 1u);
            else XB_SPIN(xb_ld(&bar[XB_TOPGEN]) == tg, bar);
            __builtin_amdgcn_fence(__ATOMIC_ACQUIRE, "agent");
            xb_add(&bar[XB_XGEN(b.x)], 1u);
            asm volatile("s_waitcnt vmcnt(0)" ::: "memory");
        } else {
            XB_SPIN(xb_ld(&bar[XB_XGEN(b.x)]) == gen, bar);
            __builtin_amdgcn_fence(__ATOMIC_ACQUIRE, "agent");
            asm volatile("s_waitcnt vmcnt(0)" ::: "memory");
        }
    }
    __syncthreads();
}

struct Frame {
    LAS unsigned char* lds;
    volatile LAS unsigned* MISC;
    gu32* ctl;
    int tid, lane, wave;
    int vcu, G;
    const float *xp, *xs, *meta, *norm_g, *w_in, *na_rpb, *sink, *wpa, *wpb, *wout, *t5, *final_g;
    float* out;
    bf16 *P, *WpT, *WoT, *U, *WinT;
    float *rpbL2, *t5L2, *sinkL2;
};

__device__ __forceinline__ float wave_sum(float v) {
#pragma unroll
    for (int o = 1; o < 64; o <<= 1) v += __shfl_xor(v, o);
    return v;
}
__device__ __forceinline__ void p0_transpose_item(const float* W, int K, int N, bf16* WT, int ldt, int row_off, int col_off, const float* gk, float sc, LAS float* scr, int item, int lane) {
    const int nblk = N / 32, kb = item / nblk, nb = item % nblk, k0 = 64 * kb, n0 = 32 * nb;
#pragma unroll 8
    for (int i = 0; i < 32; ++i) { const int kk = 2 * i + (lane >> 5); const float g = gk ? gk[k0 + kk] * sc : sc; scr[kk * 33 + (lane & 31)] = W[(size_t)(k0 + kk) * N + n0 + (lane & 31)] * g; }
    LDS_WAIT(); asm volatile("" ::: "memory");
    const int c = lane & 7;
#pragma unroll
    for (int j = 0; j < 4; ++j) { const int n = (lane >> 3) + 8 * j; const LAS float* s = scr + (8 * c) * 33 + n;
        v4u o; o.x = pk2(s[0 * 33], s[1 * 33]); o.y = pk2(s[2 * 33], s[3 * 33]); o.z = pk2(s[4 * 33], s[5 * 33]); o.w = pk2(s[6 * 33], s[7 * 33]);
        *(GAS v4u*)(WT + (size_t)(row_off + n0 + n) * ldt + col_off + k0 + 8 * c) = o; }
    LDS_WAIT(); asm volatile("" ::: "memory");
}
__device__ __forceinline__ void rms_row_to_bf16(int lane, const float* xrow, bf16* orow) {
    GAS unsigned long long* o8 = (GAS unsigned long long*)orow + lane;
    if (xrow == nullptr) {
#pragma unroll
        for (int j = 0; j < 4; ++j) o8[64 * j] = 0ull;
        return;
    }
    const GAS f32x4* xr = (const GAS f32x4*)xrow + lane;
    f32x4 v[4]; float s = 0.f;
#pragma unroll
    for (int j = 0; j < 4; ++j) { v[j] = xr[64 * j]; s += (v[j].x * v[j].x + v[j].y * v[j].y) + (v[j].z * v[j].z + v[j].w * v[j].w); }
    const float r = 1.0f / sqrtf(wave_sum(s) * (1.f / DM) + RMS_EPS);
#pragma unroll
    for (int j = 0; j < 4; ++j) o8[64 * j] = (unsigned long long)pk2(v[j].x * r, v[j].y * r) | ((unsigned long long)pk2(v[j].z * r, v[j].w * r) << 32);
}
__device__ __forceinline__ int t5_bucket(int rel) {
    const int n = rel < 0 ? -rel : rel; const int base = rel > 0 ? 16 : 0;
    if (n < 8) return base + n;
    int lg = 2 + (31 - __builtin_clz((unsigned)(n * n)));
    return base + (lg < 15 ? lg : 15);
}
__device__ __forceinline__ void p0_prologue(Frame& F) {
    LAS float* scr = (LAS float*)(F.lds + RING_OFF + F.wave * 16384);
    const int gw = F.vcu * NWAVES + F.wave, NGW = F.G * NWAVES;
    constexpr int I_IN = (DM / 64) * (NPROJ / 32), I_PA = (512 / 64) * (DM / 32), I_PB = I_PA, I_O = (DM / 64) * (DM / 32);
    constexpr int NITEMS = I_IN + I_PA + I_PB + I_O;
    for (int it = gw; it < NITEMS; it += NGW) {
        int r = it;
        if (r < I_IN) { const int n0 = 32 * (r % (NPROJ / 32)); const bool isq = (n0 < COL_KA) || (n0 >= COL_QB && n0 < COL_KB);
            p0_transpose_item(F.w_in, DM, NPROJ, F.WinT, DM, 0, 0, F.norm_g, isq ? C2 : 1.0f, scr, r, F.lane); continue; } r -= I_IN;
        if (r < I_PA) { p0_transpose_item(F.wpa, 512, DM, F.WpT, DM, 0, 0, nullptr, 1.0f, scr, r, F.lane); continue; } r -= I_PA;
        if (r < I_PB) { p0_transpose_item(F.wpb, 512, DM, F.WpT, DM, 0, 512, nullptr, 1.0f, scr, r, F.lane); continue; } r -= I_PB;
        p0_transpose_item(F.wout, DM, DM, F.WoT, DM, 0, 0, nullptr, 1.0f, scr, r, F.lane);
    }
    for (int m = gw; m < MP; m += NGW) {
        const float* src = m < N_PROMPT_ROWS ? F.xp + (size_t)m * DM : m < NTOK ? F.xs + (size_t)(m - N_PROMPT_ROWS) * DM : m < NTOK + 16 ? F.meta + (size_t)(m - NTOK) * DM : nullptr;
        rms_row_to_bf16(F.lane, src, F.U + (size_t)m * DM);
    }
    if (blockIdx.x == 0) {
        for (int i = F.tid; i < 8 * 15 * 31; i += NWAVES * 64) F.rpbL2[i] = F.na_rpb[i] * LOG2E;
        for (int i = F.tid; i < 8 * 257; i += NWAVES * 64) { const int h = i / 257, rel = i % 257 - 128; F.t5L2[i] = F.t5[t5_bucket(rel) * 8 + h] * LOG2E; }
        if (F.tid < 8) F.sinkL2[F.tid] = F.sink[F.tid] * LOG2E;
    }
}
__device__ __forceinline__ void p5_final_norm(Frame& F) {
    const int gw = F.vcu * NWAVES + F.wave, NGW = F.G * NWAVES;
    const GAS f32x4* gp = (const GAS f32x4*)F.final_g + F.lane;
    f32x4 gv[4];
#pragma unroll
    for (int j = 0; j < 4; ++j) gv[j] = gp[64 * j];
    for (int m = gw; m < NTOK; m += NGW) {
        GAS f32x4* xr = (GAS f32x4*)(F.out + (size_t)m * DM) + F.lane;
        f32x4 v[4]; float s = 0.f;
#pragma unroll
        for (int j = 0; j < 4; ++j) { v[j] = xr[64 * j]; s += (v[j].x * v[j].x + v[j].y * v[j].y) + (v[j].z * v[j].z + v[j].w * v[j].w); }
        const float r = 1.0f / sqrtf(wave_sum(s) * (1.f / DM) + RMS_EPS);
#pragma unroll
        for (int j = 0; j < 4; ++j) xr[64 * j] = v[j] * r * gv[j];
    }
}
__device__ __forceinline__ void ld64(const bf16* p, float (&f)[64]) {
    const GAS v4u* q = (const GAS v4u*)p;
#pragma unroll
    for (int i = 0; i < 8; ++i) { const v4u w = q[i]; f[8 * i + 0] = bfl(w.x); f[8 * i + 1] = bfh(w.x); f[8 * i + 2] = bfl(w.y); f[8 * i + 3] = bfh(w.y);
        f[8 * i + 4] = bfl(w.z); f[8 * i + 5] = bfh(w.z); f[8 * i + 6] = bfl(w.w); f[8 * i + 7] = bfh(w.w); }
}
__device__ __forceinline__ float dot64(const float (&q)[64], const bf16* kp) {
    const GAS v4u* k4 = (const GAS v4u*)kp; float s0 = 0.f, s1 = 0.f, s2 = 0.f, s3 = 0.f;
#pragma unroll
    for (int i = 0; i < 8; ++i) { const v4u w = k4[i];
        s0 += q[8 * i + 0] * bfl(w.x) + q[8 * i + 1] * bfh(w.x); s1 += q[8 * i + 2] * bfl(w.y) + q[8 * i + 3] * bfh(w.y);
        s2 += q[8 * i + 4] * bfl(w.z) + q[8 * i + 5] * bfh(w.z); s3 += q[8 * i + 6] * bfl(w.w) + q[8 * i + 7] * bfh(w.w); }
    return (s0 + s1) + (s2 + s3);
}
__device__ __forceinline__ void osm_update(float s, const bf16* vp, float& m, float& l, float (&o)[64]) {
    if (s > m) { const float c = __builtin_amdgcn_exp2f(m - s); l *= c;
#pragma unroll
        for (int d = 0; d < 64; ++d) o[d] *= c;
        m = s; }
    const float p = __builtin_amdgcn_exp2f(s - m); l += p;
    const GAS v4u* v4 = (const GAS v4u*)vp;
#pragma unroll
    for (int i = 0; i < 8; ++i) { const v4u w = v4[i];
        o[8 * i + 0] += p * bfl(w.x); o[8 * i + 1] += p * bfh(w.x); o[8 * i + 2] += p * bfl(w.y); o[8 * i + 3] += p * bfh(w.y);
        o[8 * i + 4] += p * bfl(w.z); o[8 * i + 5] += p * bfh(w.z); o[8 * i + 6] += p * bfl(w.w); o[8 * i + 7] += p * bfh(w.w); }
}
__device__ __forceinline__ void finish_gate(bf16* zp, float l, const float (&o)[64]) {
    const float rl = 1.0f / l;
    GAS v4u* z4 = (GAS v4u*)zp;
#pragma unroll
    for (int i = 0; i < 8; ++i) { const v4u w = z4[i]; float z[8] = {bfl(w.x), bfh(w.x), bfl(w.y), bfh(w.y), bfl(w.z), bfh(w.z), bfl(w.w), bfh(w.w)}; float r[8];
#pragma unroll
        for (int e = 0; e < 8; ++e) { const float sg = 1.0f / (1.0f + __builtin_amdgcn_exp2f(-LOG2E * z[e])); r[e] = o[8 * i + e] * rl * z[e] * sg; }
        v4u ov; ov.x = pk2(r[0], r[1]); ov.y = pk2(r[2], r[3]); ov.z = pk2(r[4], r[5]); ov.w = pk2(r[6], r[7]); z4[i] = ov; }
}
__device__ __forceinline__ void batch_of(int t, int& tb, int& n) { if (t < N_PROMPT_ROWS) { tb = t & ~16383; n = 16384; } else { tb = N_PROMPT_ROWS + ((t - N_PROMPT_ROWS) & ~4095); n = 4096; } }

__device__ __forceinline__ void attn_scalar_na(bf16* P, const float* rpbL2, int gtid, int gthreads) {
    for (int id = gtid; id < NTOK * 8; id += gthreads) {
        const int t = id >> 3, h = id & 7; int tb, n; batch_of(t, tb, n);
        const int tl = t - tb, rows = n >> 6, i = tl >> 6, j = tl & 63;
        const int rs = min(max(i - 4, 0), rows - 8), cs = min(max(j - 8, 0), 48);
        float q[64], o[64]; ld64(P + (size_t)t * NPROJ + COL_QA + h * 64, q);
#pragma unroll
        for (int d = 0; d < 64; ++d) o[d] = 0.f;
        float m = -1e30f, l = 0.f;
        for (int a = 0; a < 8; ++a) {
            const float* brow = rpbL2 + (h * 15 + (rs + a - i + 7)) * 31 + (cs - j + 15);
            const bf16* krow = P + (size_t)(tb + (rs + a) * 64 + cs) * NPROJ + h * 64;
            for (int c = 0; c < 16; ++c) { const bf16* kr = krow + (size_t)c * NPROJ;
                const float s = dot64(q, kr + COL_KA) + brow[c]; osm_update(s, kr + COL_VA, m, l, o); }
        }
        for (int mm = 0; mm < 16; ++mm) { const bf16* kr = P + (size_t)(META_ROW + mm) * NPROJ + h * 64;
            const float s = dot64(q, kr + COL_KA); osm_update(s, kr + COL_VA, m, l, o); }
        finish_gate(P + (size_t)t * NPROJ + COL_ZA + h * 64, l, o);
    }
}
__device__ __forceinline__ void attn_scalar_wa(bf16* P, const float* t5L2, const float* sinkL2, int gtid, int gthreads) {
    for (int id = gtid; id < NTOK * 8; id += gthreads) {
        const int t = id >> 3, h = id & 7, kh = h >> 2; int tb, n; batch_of(t, tb, n);
        const int tl = t - tb;
        float q[64], o[64]; ld64(P + (size_t)t * NPROJ + COL_QB + h * 64, q);
#pragma unroll
        for (int d = 0; d < 64; ++d) o[d] = 0.f;
        float m = -1e30f, l = 0.f;
        const int s0 = max(tl - 128, 0), s1 = min(tl + 128, n - 1);
        const float* tb5 = t5L2 + h * 257;
        for (int s = s0; s <= s1; ++s) { const bf16* kr = P + (size_t)(tb + s) * NPROJ + kh * 64;
            const float sc = dot64(q, kr + COL_KB) + tb5[s - tl + 128]; osm_update(sc, kr + COL_VB, m, l, o); }
        for (int mm = 0; mm < 16; ++mm) { const bf16* kr = P + (size_t)(META_ROW + mm) * NPROJ + kh * 64;
            const int nn = min(tl + 16 - mm, 128);
            const float sc = dot64(q, kr + COL_KB) + tb5[128 - nn]; osm_update(sc, kr + COL_VB, m, l, o); }
        { const float sk = sinkL2[h]; if (sk > m) { const float c = __builtin_amdgcn_exp2f(m - sk); l *= c;
#pragma unroll
              for (int d = 0; d < 64; ++d) o[d] *= c;
              m = sk; }
          l += __builtin_amdgcn_exp2f(sk - m); }
        finish_gate(P + (size_t)t * NPROJ + COL_ZB + h * 64, l, o);
    }
}
struct Args { const float* in[12]; float* out; unsigned char* ws; int ph_lo, ph_hi, li, pad; };
__global__ void __launch_bounds__(NWAVES * 64, 2) mk_fwd(Args args) {
    extern __shared__ __attribute__((aligned(16))) unsigned char lds[];
    Frame F;
    F.lds = (LAS unsigned char*)lds;
    F.MISC = (volatile LAS unsigned*)(F.lds + MISC_OFF);
    F.tid = threadIdx.x; F.lane = F.tid & 63; F.wave = __builtin_amdgcn_readfirstlane(F.tid >> 6);
    F.G = gridDim.x; { const int bx = blockIdx.x; F.vcu = (F.G % 8 == 0) ? (bx % 8) * (F.G / 8) + bx / 8 : bx; }
    unsigned char* ws = args.ws;
    F.ctl = (gu32*)(ws + WS_CTL);
    F.xp = args.in[0]; F.xs = args.in[1]; F.meta = args.in[2]; F.norm_g = args.in[3]; F.w_in = args.in[4]; F.na_rpb = args.in[5]; F.sink = args.in[6];
    F.wpa = args.in[7]; F.wpb = args.in[8]; F.wout = args.in[9]; F.t5 = args.in[10]; F.final_g = args.in[11]; F.out = args.out;
    F.P = (bf16*)(ws + WS_P); F.WpT = (bf16*)(ws + WS_WP); F.WoT = (bf16*)(ws + WS_WO);
    F.U = (bf16*)((unsigned char*)args.out + DO_U); F.WinT = (bf16*)((unsigned char*)args.out + DO_WIN);
    F.rpbL2 = (float*)(ws + WS_TAB + TAB_RPB); F.t5L2 = (float*)(ws + WS_TAB + TAB_T5); F.sinkL2 = (float*)(ws + WS_TAB + TAB_SINK);
    for (int u = F.tid; u < (LDS_BYTES - LDSCTL_OFF) / 4; u += NWAVES * 64) ((LAS unsigned*)(F.lds + LDSCTL_OFF))[u] = 0u;
    __syncthreads();
    XcdBarrier bar; bar.bar = (unsigned*)(F.ctl + CW_BAR); bar.x = 0; bar.st = nullptr;
    if (N_LAUNCHES != PER_PHASE) bar = xcd_barrier_post((unsigned*)(F.ctl + CW_BAR), F.MISC + 8);
#define GRID_BAR() do { if (N_LAUNCHES != PER_PHASE) xcd_barrier(bar); } while (0)
    const int lo = args.ph_lo, hi = args.ph_hi;
#define IN(k) (lo <= (k) && (k) < hi)
#define BOTH(k) (IN(k) && IN((k) + 1))
    if (IN(0)) { p0_prologue(F); if (BOTH(0)) GRID_BAR(); }
    if (IN(1)) {
        pg8::Gemm g{F.U, F.WinT, MP, NPROJ, DM, DM, DM}; pg8::StaticOrder S; S.init(MP, NPROJ, F.G, (int)blockIdx.x);
        pg8::EpiStoreBf16 E{F.P, NPROJ};
        pg8::gemm_phase<pg8::EpiStoreBf16, pg8::StaticOrder, PG8_ALIGN, PG8_SP2>(F.lds + RING_OFF, g, S, E);
        if (BOTH(1)) GRID_BAR();
    }
    if (IN(2)) {
        const int gtid = F.vcu * (NWAVES * 64) + F.tid, gthreads = F.G * NWAVES * 64;
        attn_scalar_na(F.P, F.rpbL2, gtid, gthreads);
        attn_scalar_wa(F.P, F.t5L2, F.sinkL2, gtid, gthreads);
        if (BOTH(2)) GRID_BAR();
    }
    if (IN(3)) {
        { pg8::Gemm g{F.P + COL_ZA, F.WpT, NTOK, DM, 512, NPROJ, DM}; pg8::StaticOrder S; S.init(NTOK, DM, F.G, (int)blockIdx.x);
          pg8::EpiGate<false> E{F.P, NPROJ, COL_GA};
          pg8::gemm_phase<pg8::EpiGate<false>, pg8::StaticOrder, PG8_ALIGN, PG8_SP2>(F.lds + RING_OFF, g, S, E); }
        { pg8::Gemm g{F.P + COL_ZB, F.WpT + 512, NTOK, DM, 512, NPROJ, DM}; pg8::StaticOrder S; S.init(NTOK, DM, F.G, (int)blockIdx.x);
          pg8::EpiGate<true> E{F.P, NPROJ, COL_GB};
          pg8::gemm_phase<pg8::EpiGate<true>, pg8::StaticOrder, PG8_ALIGN, PG8_SP2>(F.lds + RING_OFF, g, S, E); }
        if (BOTH(3)) GRID_BAR();
    }
    if (IN(4)) {
        pg8::Gemm g{F.P, F.WoT, NTOK, DM, DM, NPROJ, DM}; pg8::StaticOrder S; S.init(NTOK, DM, F.G, (int)blockIdx.x);
        pg8::EpiResF32 E{F.xp, F.xs, N_PROMPT_ROWS, F.out, DM};
        pg8::gemm_phase<pg8::EpiResF32, pg8::StaticOrder, PG8_ALIGN, PG8_SP2>(F.lds + RING_OFF, g, S, E);
        if (BOTH(4)) GRID_BAR();
    }
    if (IN(5)) { p5_final_norm(F); }
#undef IN
#undef BOTH
}

extern "C" void kernel_launch(void* const* d_in, const int* in_sizes, int n_in, void* d_out, int out_size, void* d_ws, size_t ws_size, hipStream_t stream) {
    static int grid = 0;
    if (grid == 0) {
        if (n_in != 12 || out_size != NTOK * DM || ws_size < WS_END) { fprintf(stderr, "kernel_launch: unexpected shapes: n_in %d out %d ws %zu (need %zu)\n", n_in, out_size, ws_size, (size_t)WS_END); grid = -1; return; }
        int dev = 0, cus = 0;
        if (hipGetDevice(&dev) != hipSuccess || hipDeviceGetAttribute(&cus, hipDeviceAttributeMultiprocessorCount, dev) != hipSuccess) { grid = -1; return; }
        if (hipFuncSetAttribute((const void*)mk_fwd, hipFuncAttributeMaxDynamicSharedMemorySize, LDS_BYTES) != hipSuccess) { fprintf(stderr, "kernel_launch: hipFuncSetAttribute failed\n"); grid = -1; return; }
        (void)hipGetLastError();
        grid = cus;
    }
    if (grid < 0) return;
    (void)hipMemsetAsync((char*)d_ws + WS_CTL, 0, CTL_ZERO_BYTES, stream);
    Args a{};
    for (int i = 0; i < 12; ++i) a.in[i] = (const float*)d_in[i];
    a.out = (float*)d_out; a.ws = (unsigned char*)d_ws;
    for (int li = 0; li < N_LAUNCHES; ++li) {
        a.ph_lo = (N_LAUNCHES == PER_PHASE) ? li : 0; a.ph_hi = (N_LAUNCHES == PER_PHASE) ? li + 1 : PER_PHASE; a.li = li;
        hipLaunchKernelGGL(mk_fwd, dim3(grid), dim3(NWAVES * 64), LDS_BYTES, stream, a);
    }
}
```

```cpp
#define MK_N_LAUNCHES 1
#include <hip/hip_runtime.h>
#include <cstdio>
#include <cstdint>
namespace pg8 {
#define PG8_LAS __attribute__((address_space(3)))
typedef unsigned short bf16_t;
typedef short bf16x8 __attribute__((ext_vector_type(8)));
typedef float f32x4 __attribute__((ext_vector_type(4)));
typedef unsigned u32x4 __attribute__((ext_vector_type(4)));
constexpr int BM = 256, BK = 64, HALF = 128, HTB = HALF * BK * 2  , STAGE_BYTES = 8 * HTB, NXCD = 8, WGM = 8;

__host__ __device__ __forceinline__ int lds_byte(int r, int c) { const int st = (r >> 4) * 2 + (c >> 5), rr = r & 15, cc = c & 31, ob = rr * 64 + cc * 2; return st * 1024 + (ob ^ (((ob >> 9) & 1) << 5)); }
__host__ __device__ __forceinline__ void stage_rc(int b, int& R, int& C) { const int st = b / 1024, sb = b % 1024, swz = sb ^ (((sb >> 9) & 1) << 5); R = (st >> 1) * 16 + swz / 64; C = (st & 1) * 32 + (swz % 64) / 2; }
__host__ __device__ __forceinline__ int perm32(int rho) { const int n = rho >> 4, i = rho & 15; return 8 * (i >> 2) + 4 * n + (i & 3); }

struct Unit { int pm, pn; };
struct Gemm { const bf16_t* A; const bf16_t* Bt; int M, N, K, lda, ldb; };

struct StaticOrder {
    int nM, nN, nwg, G, c;
    __host__ __device__ void init(int M, int N, int G_, int c_) { nM = M / BM; nN = N / BM; nwg = nM * nN; G = G_; c = c_; }
    __host__ __device__ bool next(int i, Unit& u) const {
        const long L = (long)i * G + c; if (L >= nwg) return false;
        int wgid = (int)L; { const int q = nwg / NXCD, r = nwg % NXCD, xcd = wgid % NXCD, off = wgid / NXCD; wgid = (xcd < r ? xcd * (q + 1) : r * (q + 1) + (xcd - r) * q) + off; }
        const int nig = WGM * nN, gid = wgid / nig, fm = gid * WGM, gsz = (nM - fm) < WGM ? (nM - fm) : WGM;
        u.pm = fm + ((wgid % nig) % gsz); u.pn = (wgid % nig) / gsz; return true;
    }
    __device__ __forceinline__ void a_ready(const Unit&) const {}
    __device__ __forceinline__ void done(const Unit&) const {}
};

__device__ __forceinline__ unsigned cvt_pk_bf16(float lo, float hi) { unsigned r; asm volatile("v_cvt_pk_bf16_f32 %0, %1, %2" : "=v"(r) : "v"(lo), "v"(hi)); return r; }
__device__ __forceinline__ float bf_lo(unsigned w) { return __uint_as_float(w << 16); }
__device__ __forceinline__ float bf_hi(unsigned w) { return __uint_as_float(w & 0xffff0000u); }
__device__ __forceinline__ float sigmoidf_fast(float g) { return __builtin_amdgcn_rcpf(1.0f + __builtin_amdgcn_exp2f(-1.4426950408889634f * g)); }
struct EpiStoreBf16 {
    static constexpr bool PERM = true, AFTER_DRAIN = false;
    bf16_t* O; int ldc;
    __device__ __forceinline__ void operator()(const f32x4 (&acc)[2][2][4][2], const Unit& u, int wr, int wc, int fr, int fq) const {
        const int row0 = u.pm * BM + wr * 64 + fr; const int col0 = u.pn * BM + wc * 32 + 8 * fq;
#pragma unroll
        for (int ai = 0; ai < 2; ++ai)
#pragma unroll
            for (int m = 0; m < 4; ++m) { bf16_t* rowp = O + (size_t)(row0 + ai * HALF + m * 16) * ldc + col0;
#pragma unroll
                for (int bj = 0; bj < 2; ++bj) { const f32x4 v0 = acc[ai][bj][m][0], v1 = acc[ai][bj][m][1];
                    u32x4 w; w.x = cvt_pk_bf16(v0[0], v0[1]); w.y = cvt_pk_bf16(v0[2], v0[3]); w.z = cvt_pk_bf16(v1[0], v1[1]); w.w = cvt_pk_bf16(v1[2], v1[3]);
                    *(u32x4*)(rowp + bj * HALF) = w; } }
    }
};
template <bool ADD> struct EpiGate {
    static constexpr bool PERM = true, AFTER_DRAIN = false;
    bf16_t* P; int ldc; int gate_col;
    __device__ __forceinline__ void operator()(const f32x4 (&acc)[2][2][4][2], const Unit& u, int wr, int wc, int fr, int fq) const {
        const int row0 = u.pm * BM + wr * 64 + fr; const int col0 = u.pn * BM + wc * 32 + 8 * fq;
#pragma unroll
        for (int ai = 0; ai < 2; ++ai)
#pragma unroll
            for (int m = 0; m < 4; ++m) { bf16_t* rowp = P + (size_t)(row0 + ai * HALF + m * 16) * ldc + col0;
#pragma unroll
                for (int bj = 0; bj < 2; ++bj) { const f32x4 v0 = acc[ai][bj][m][0], v1 = acc[ai][bj][m][1];
                    const u32x4 gw = *(const u32x4*)(rowp + gate_col + bj * HALF);
                    float r[8];
                    r[0] = v0[0] * sigmoidf_fast(bf_lo(gw.x)); r[1] = v0[1] * sigmoidf_fast(bf_hi(gw.x));
                    r[2] = v0[2] * sigmoidf_fast(bf_lo(gw.y)); r[3] = v0[3] * sigmoidf_fast(bf_hi(gw.y));
                    r[4] = v1[0] * sigmoidf_fast(bf_lo(gw.z)); r[5] = v1[1] * sigmoidf_fast(bf_hi(gw.z));
                    r[6] = v1[2] * sigmoidf_fast(bf_lo(gw.w)); r[7] = v1[3] * sigmoidf_fast(bf_hi(gw.w));
                    if (ADD) { const u32x4 pw = *(const u32x4*)(rowp + bj * HALF);
                        r[0] += bf_lo(pw.x); r[1] += bf_hi(pw.x); r[2] += bf_lo(pw.y); r[3] += bf_hi(pw.y);
                        r[4] += bf_lo(pw.z); r[5] += bf_hi(pw.z); r[6] += bf_lo(pw.w); r[7] += bf_hi(pw.w); }
                    u32x4 w; w.x = cvt_pk_bf16(r[0], r[1]); w.y = cvt_pk_bf16(r[2], r[3]); w.z = cvt_pk_bf16(r[4], r[5]); w.w = cvt_pk_bf16(r[6], r[7]);
                    *(u32x4*)(rowp + bj * HALF) = w; } }
    }
};
struct EpiResF32 {
    static constexpr bool PERM = false, AFTER_DRAIN = false;
    const float* xa; const float* xb; int nsplit; float* out; int ldc;
    __device__ __forceinline__ void operator()(const f32x4 (&acc)[2][2][4][2], const Unit& u, int wr, int wc, int fr, int fq) const {
        const int row0 = u.pm * BM + wr * 64 + fr, col0 = u.pn * BM + wc * 32 + 4 * fq;
#pragma unroll
        for (int ai = 0; ai < 2; ++ai)
#pragma unroll
            for (int m = 0; m < 4; ++m) { const int row = row0 + ai * HALF + m * 16;
                const float* xr = (row < nsplit ? xa + (size_t)row * ldc : xb + (size_t)(row - nsplit) * ldc) + col0;
                float* rowp = out + (size_t)row * ldc + col0;
#pragma unroll
                for (int bj = 0; bj < 2; ++bj)
#pragma unroll
                    for (int n = 0; n < 2; ++n) *(f32x4*)(rowp + bj * HALF + n * 16) = acc[ai][bj][m][n] + *(const f32x4*)(xr + bj * HALF + n * 16); }
    }
};
template <class Epi, class Sched, bool ALIGN_EPI = false, bool SP2 = false>
__device__ __forceinline__ void gemm_phase(PG8_LAS unsigned char* lds, const Gemm g, const Sched& S, const Epi& E) {
    const int tid = threadIdx.x, wid = __builtin_amdgcn_readfirstlane(tid >> 6), lane = tid & 63, wr = wid >> 2, wc = wid & 3, fr = lane & 15, fq = lane >> 4;
    const int K = g.K, nt = K / BK;
    unsigned voffA[2], voffB[2];
#pragma unroll
    for (int i = 0; i < 2; ++i) { int R, C; stage_rc(tid * 16 + i * 8192, R, C); const int Rb = Epi::PERM ? ((R & ~31) + perm32(R & 31)) : R;
        voffA[i] = (unsigned)(R * g.lda + C) * 2u; voffB[i] = (unsigned)(Rb * g.ldb + C) * 2u; }
    const size_t kstep = (size_t)(BK * 2);
    const size_t hstepA = (size_t)HALF * g.lda * 2, hstepB = (size_t)HALF * g.ldb * 2;
    const size_t tstepA = 2 * hstepA, tstepB = 2 * hstepB;
    const unsigned ldsw = (unsigned)wid * 1024u;
    const int aoff = lds_byte(wr * 64 + fr, fq * 8), boff = lds_byte(wc * 32 + fr, fq * 8);
#define PG8_SA(b, h) (((b) * 2 + (h)) * HTB)
#define PG8_SB(b, h) ((4 + (b) * 2 + (h)) * HTB)
#define PG8_STAGE(bufoff, gbase, voff) do { _Pragma("unroll") for (int _i = 0; _i < 2; ++_i) \
        __builtin_amdgcn_global_load_lds((const unsigned*)((const char*)(gbase) + (voff)[_i]), (PG8_LAS unsigned*)(lds + (bufoff) + ldsw + _i * 8192), 16, 0, 0); } while (0)
#define PG8_LDA(dst, b, h) do { _Pragma("unroll") for (int m = 0; m < 4; ++m) _Pragma("unroll") for (int k = 0; k < 2; ++k) dst[m][k] = *(const PG8_LAS bf16x8*)(lds + PG8_SA(b, h) + aoff + m * 2048 + k * 1024); } while (0)
#define PG8_LDB(dst, b, h) do { _Pragma("unroll") for (int n = 0; n < 2; ++n) _Pragma("unroll") for (int k = 0; k < 2; ++k) dst[n][k] = *(const PG8_LAS bf16x8*)(lds + PG8_SB(b, h) + boff + n * 2048 + k * 1024); } while (0)
#define PG8_MMA(ai, bj, At, Bt) do { __builtin_amdgcn_s_setprio(1); _Pragma("unroll") for (int m = 0; m < 4; ++m) _Pragma("unroll") for (int n = 0; n < 2; ++n) _Pragma("unroll") for (int k = 0; k < 2; ++k) \
        acc[ai][bj][m][n] = __builtin_amdgcn_mfma_f32_16x16x32_bf16(Bt[n][k], At[m][k], acc[ai][bj][m][n], 0, 0, 0); __builtin_amdgcn_s_setprio(0); } while (0)
#define PG8_WAIT_V(n) asm volatile("s_waitcnt vmcnt(" #n ")" ::: "memory")
#define PG8_WAIT_L(n) asm volatile("s_waitcnt lgkmcnt(" #n ")" ::: "memory")
#define PG8_BAR __builtin_amdgcn_s_barrier()
#define PG8_SCHED __builtin_amdgcn_sched_barrier(0)
    Unit cur, nxt; int ui = 0;
    if (!S.next(0, cur)) return;
    f32x4 acc[2][2][4][2];
#pragma unroll
    for (int a = 0; a < 2; ++a)
#pragma unroll
        for (int b = 0; b < 2; ++b)
#pragma unroll
            for (int m = 0; m < 4; ++m)
#pragma unroll
                for (int n = 0; n < 2; ++n) acc[a][b][m][n] = (f32x4){0.f, 0.f, 0.f, 0.f};
    bf16x8 At[4][2], B0[2][2], B1[2][2];
    const char* cA = (const char*)g.A + (size_t)cur.pm * tstepA; const char* cB = (const char*)g.Bt + (size_t)cur.pn * tstepB;
    S.a_ready(cur);
    if constexpr (SP2) {
        PG8_STAGE(PG8_SB(0, 0), cB, voffB); PG8_STAGE(PG8_SB(0, 1), cB + hstepB, voffB); PG8_STAGE(PG8_SA(0, 0), cA, voffA); PG8_STAGE(PG8_SA(0, 1), cA + hstepA, voffA);
        if (wr == 1) PG8_BAR;
        PG8_WAIT_V(2); PG8_BAR;
        PG8_STAGE(PG8_SB(1, 0), cB + kstep, voffB); PG8_STAGE(PG8_SA(1, 0), cA + kstep, voffA); PG8_STAGE(PG8_SB(1, 1), cB + hstepB + kstep, voffB);
        PG8_WAIT_V(6); PG8_BAR;
    } else {
        PG8_STAGE(PG8_SB(0, 0), cB, voffB); PG8_STAGE(PG8_SA(0, 0), cA, voffA); PG8_STAGE(PG8_SB(0, 1), cB + hstepB, voffB); PG8_STAGE(PG8_SA(0, 1), cA + hstepA, voffA);
        if (wr == 1) PG8_BAR;
        PG8_WAIT_V(4); PG8_BAR;
        PG8_STAGE(PG8_SB(1, 0), cB + kstep, voffB); PG8_STAGE(PG8_SA(1, 0), cA + kstep, voffA); PG8_STAGE(PG8_SB(1, 1), cB + hstepB + kstep, voffB);
        PG8_WAIT_V(6); PG8_BAR;
    }
    for (;;) {
        const bool has_next = S.next(ui + 1, nxt);
        const char* nA = has_next ? (const char*)g.A + (size_t)nxt.pm * tstepA : cA; const char* nB = has_next ? (const char*)g.Bt + (size_t)nxt.pn * tstepB : cB;
        for (int t = 0; t < nt; t += 2) {
            const bool last = (t == nt - 2);
            const char* a1 = cA + (size_t)(t + 1) * kstep;
            const char* a2 = last ? nA : cA + (size_t)(t + 2) * kstep; const char* b2 = last ? nB : cB + (size_t)(t + 2) * kstep;
            const char* a3 = a2 + kstep; const char* b3 = b2 + kstep;
            if (last && has_next) S.a_ready(nxt);
            if constexpr (SP2) {
            PG8_LDB(B0, 0, 0); PG8_LDB(B1, 0, 1); PG8_SCHED; PG8_LDA(At, 0, 0); PG8_STAGE(PG8_SA(1, 1), a1 + hstepA, voffA);
            PG8_WAIT_V(8); PG8_WAIT_L(0); PG8_BAR; PG8_MMA(0, 0, At, B0); PG8_MMA(0, 1, At, B1); PG8_BAR; PG8_SCHED;
            PG8_LDA(At, 0, 1); PG8_STAGE(PG8_SB(0, 0), b2, voffB); PG8_STAGE(PG8_SB(0, 1), b2 + hstepB, voffB); PG8_STAGE(PG8_SA(0, 0), a2, voffA);
            PG8_WAIT_V(8); PG8_WAIT_L(0); PG8_BAR; PG8_MMA(1, 0, At, B0); PG8_MMA(1, 1, At, B1); PG8_BAR; PG8_SCHED;
            PG8_LDB(B0, 1, 0); PG8_LDB(B1, 1, 1); PG8_SCHED; PG8_LDA(At, 1, 0); PG8_STAGE(PG8_SA(0, 1), a2 + hstepA, voffA);
            PG8_WAIT_V(8); PG8_WAIT_L(0); PG8_BAR; PG8_MMA(0, 0, At, B0); PG8_MMA(0, 1, At, B1); PG8_BAR; PG8_SCHED;
            PG8_LDA(At, 1, 1); PG8_STAGE(PG8_SB(1, 0), b3, voffB); PG8_STAGE(PG8_SB(1, 1), b3 + hstepB, voffB); PG8_STAGE(PG8_SA(1, 0), a3, voffA);
            PG8_WAIT_V(8); PG8_WAIT_L(0); PG8_BAR; PG8_MMA(1, 0, At, B0); PG8_MMA(1, 1, At, B1); PG8_BAR; PG8_SCHED;
            } else {
            PG8_LDB(B0, 0, 0); PG8_SCHED; PG8_LDA(At, 0, 0); PG8_STAGE(PG8_SA(1, 1), a1 + hstepA, voffA);
            PG8_WAIT_L(8); PG8_BAR; PG8_WAIT_L(0); PG8_MMA(0, 0, At, B0); PG8_BAR; PG8_SCHED;
            PG8_LDB(B1, 0, 1); PG8_STAGE(PG8_SB(0, 0), b2, voffB);
            PG8_BAR; PG8_WAIT_L(0); PG8_MMA(0, 1, At, B1); PG8_BAR;
            PG8_LDA(At, 0, 1); PG8_STAGE(PG8_SA(0, 0), a2, voffA);
            PG8_BAR; PG8_WAIT_L(0); PG8_MMA(1, 0, At, B0); PG8_BAR; PG8_SCHED;
            PG8_STAGE(PG8_SB(0, 1), b2 + hstepB, voffB);
            PG8_WAIT_V(6); PG8_BAR; PG8_MMA(1, 1, At, B1); PG8_BAR;
            PG8_LDB(B0, 1, 0); PG8_SCHED; PG8_LDA(At, 1, 0); PG8_STAGE(PG8_SA(0, 1), a2 + hstepA, voffA);
            PG8_WAIT_L(8); PG8_BAR; PG8_WAIT_L(0); PG8_MMA(0, 0, At, B0); PG8_BAR; PG8_SCHED;
            PG8_LDB(B1, 1, 1); PG8_STAGE(PG8_SB(1, 0), b3, voffB);
            PG8_BAR; PG8_WAIT_L(0); PG8_MMA(0, 1, At, B1); PG8_BAR;
            PG8_LDA(At, 1, 1); PG8_STAGE(PG8_SA(1, 0), a3, voffA);
            PG8_BAR; PG8_WAIT_L(0); PG8_MMA(1, 0, At, B0); PG8_BAR; PG8_SCHED;
            PG8_STAGE(PG8_SB(1, 1), b3 + hstepB, voffB);
            PG8_WAIT_V(6); PG8_BAR; PG8_MMA(1, 1, At, B1); PG8_BAR;
            }
        }
        if constexpr (ALIGN_EPI) { if (wr == 0) PG8_BAR; }
        if constexpr (!Epi::AFTER_DRAIN) { E(acc, cur, wr, wc, fr, fq); S.done(cur); }
        if (!has_next) break;
#pragma unroll
        for (int a = 0; a < 2; ++a)
#pragma unroll
            for (int b = 0; b < 2; ++b)
#pragma unroll
                for (int m = 0; m < 4; ++m)
#pragma unroll
                    for (int n = 0; n < 2; ++n) acc[a][b][m][n] = (f32x4){0.f, 0.f, 0.f, 0.f};
        cur = nxt; cA = nA; cB = nB; ++ui;
        if constexpr (ALIGN_EPI) { if (wr == 1) PG8_BAR; }
    }
    PG8_WAIT_V(0);
    if constexpr (!ALIGN_EPI) { if (wr == 0) PG8_BAR; }
    PG8_BAR;
    if constexpr (Epi::AFTER_DRAIN) { E.fused(acc, cur, wr, wc, fr, fq, lds, wid, lane); S.done(cur); }
#undef PG8_SA
#undef PG8_SB
#undef PG8_STAGE
#undef PG8_LDA
#undef PG8_LDB
#undef PG8_MMA
#undef PG8_WAIT_V
#undef PG8_WAIT_L
#undef PG8_BAR
#undef PG8_SCHED
}
}

#ifndef PG8_SP2
#define PG8_SP2 true
#endif
#ifndef PG8_ALIGN
#define PG8_ALIGN true
#endif

constexpr int NWAVES = 8;
#ifndef MK_N_LAUNCHES
#define MK_N_LAUNCHES 1
#endif
constexpr int N_LAUNCHES = MK_N_LAUNCHES;
constexpr int PER_PHASE = 6;

constexpr int DM = 1024, NTOK = 98304, MP = 98560, NPROJ = 5376, N_PROMPT_ROWS = 32768, META_ROW = 98304;
constexpr int COL_QA = 0, COL_KA = 512, COL_VA = 1024, COL_ZA = 1536, COL_QB = 2048, COL_KB = 2560, COL_VB = 2688, COL_ZB = 2816, COL_GA = 3328, COL_GB = 4352;
constexpr float RMS_EPS = 1e-6f;
constexpr float LOG2E = 1.4426950408889634f;
constexpr float C2 = 0.125f * LOG2E;

constexpr size_t MiB = 1u << 20;
constexpr size_t WS_CTL = 0, CTL_ZERO_BYTES = 1 * MiB;
constexpr size_t WS_P = 1 * MiB;
constexpr size_t WS_WP = WS_P + (size_t)MP * NPROJ * 2;
constexpr size_t WS_WO = WS_WP + 2 * MiB;
constexpr size_t WS_TAB = WS_WO + 2 * MiB;
constexpr size_t TAB_RPB = 0, TAB_T5 = 16384, TAB_SINK = 32768;
constexpr size_t WS_END = WS_TAB + 65536;
static_assert(WS_END <= 1073741824ull, "d_ws map exceeds the guaranteed 1 GiB");
constexpr size_t DO_U = 0;
constexpr size_t DO_WIN = 256 * MiB;
static_assert(DO_U + (size_t)MP * DM * 2 <= DO_WIN && DO_WIN + (size_t)NPROJ * DM * 2 <= (size_t)NTOK * DM * 4, "d_out scratch map");
constexpr int CW_TMO = 0, CW_CODE = 1, CW_BAR = 4096;

constexpr int RING_OFF = 0, RING_BYTES = 131072;
constexpr int LDSCTL_OFF = RING_BYTES, MISC_OFF = LDSCTL_OFF + 320;
constexpr int LDS_BYTES = 157696;

#define GAS __attribute__((address_space(1)))
#define LAS __attribute__((address_space(3)))
typedef unsigned short bf16;
typedef unsigned v4u __attribute__((ext_vector_type(4)));
typedef float f32x4 __attribute__((ext_vector_type(4)));
typedef GAS unsigned gu32;
#define RLX_AGENT __ATOMIC_RELAXED, __HIP_MEMORY_SCOPE_AGENT
#define LDS_WAIT() asm volatile("s_waitcnt lgkmcnt(0)" ::: "memory")
#define VM_WAIT() asm volatile("s_waitcnt vmcnt(0)" ::: "memory")
__device__ __forceinline__ unsigned f2bf(float f) { unsigned u = __builtin_bit_cast(unsigned, f); return (u + 0x7fffu + ((u >> 16) & 1u)) >> 16; }
__device__ __forceinline__ unsigned pk2(float lo, float hi) { return f2bf(lo) | (f2bf(hi) << 16); }
__device__ __forceinline__ float bfl(unsigned w) { return __uint_as_float(w << 16); }
__device__ __forceinline__ float bfh(unsigned w) { return __uint_as_float(w & 0xffff0000u); }

#define XB_TMO      128
#define XB_XCNT(j)  (256  + 64 * (j))
#define XB_XSUB(j)  (1280 + 64 * (j))
#define XB_XGEN(j)  (2304 + 64 * (j))
#define XB_TOP      3328
#define XB_TOPGEN   3392
#define XCD_BAR_WORDS 3456
#define XB_SPIN_CAP (1u << 23)
__device__ __forceinline__ unsigned xb_ld(unsigned* p)              { return __hip_atomic_load(p, __ATOMIC_RELAXED, __HIP_MEMORY_SCOPE_AGENT); }
__device__ __forceinline__ unsigned xb_add(unsigned* p, unsigned v) { return __hip_atomic_fetch_add(p, v, __ATOMIC_RELAXED, __HIP_MEMORY_SCOPE_AGENT); }
__device__ __forceinline__ unsigned xb_xcc_id() { return (unsigned)__builtin_amdgcn_s_getreg((3 << 11) | 20) & 0xFu; }
#define XB_SPIN(cond, bar) do { unsigned _sp = 0; while (cond) { __builtin_amdgcn_s_sleep(1); \
    if ((++_sp & 255u) == 0u) { if (xb_ld(&(bar)[XB_TMO])) break; if (_sp > XB_SPIN_CAP) { atomicAdd(&(bar)[XB_TMO], 1u); break; } } } } while (0)
struct XcdBarrier { unsigned* bar; unsigned x; volatile LAS unsigned* st; };
__device__ __forceinline__ XcdBarrier xcd_barrier_post(unsigned* bar, volatile LAS unsigned* st) {
    XcdBarrier b; b.bar = bar; b.x = xb_xcc_id(); b.st = st;
    if (threadIdx.x == 0) (void)xb_add(&bar[XB_XCNT(b.x)], 1u);
    return b;
}
__device__ __forceinline__ void xcd_barrier_complete(unsigned* bar, unsigned x, unsigned& nloc, unsigned& nx) {
    const unsigned G = gridDim.x * gridDim.y * gridDim.z;
    unsigned sum, cnt, mine, sp = 0u;
    for (;;) {
        sum = 0u; cnt = 0u; mine = 0u;
#pragma unroll
        for (unsigned j = 0; j < 16; ++j) { const unsigned c = xb_ld(&bar[XB_XCNT(j)]); sum += c; cnt += (c > 0u) ? 1u : 0u; mine = (j == x) ? c : mine; }
        if (sum == G) break;
        __builtin_amdgcn_s_sleep(1);
        if ((++sp & 255u) == 0u) { if (xb_ld(&bar[XB_TMO])) break; if (sp > XB_SPIN_CAP) { atomicAdd(&bar[XB_TMO], 1u); break; } }
    }
    nloc = mine > 0u ? mine : 1u; nx = cnt > 0u ? cnt : 1u;
}
__device__ __forceinline__ void xcd_barrier(const XcdBarrier& b) {
    asm volatile("s_waitcnt vmcnt(0)" ::: "memory");
    __syncthreads();
    if (threadIdx.x == 0) {
        unsigned* bar = b.bar;
        __builtin_amdgcn_s_waitcnt(0);
        unsigned nloc = b.st[0], nx = b.st[1];
        if (nloc == 0u) { xcd_barrier_complete(bar, b.x, nloc, nx); b.st[0] = nloc; b.st[1] = nx; }
        const unsigned old = xb_add(&bar[XB_XSUB(b.x)], 1u);
        const unsigned gen = old / nloc;
        if (old + 1u == (gen + 1u) * nloc) {
            __builtin_amdgcn_fence(__ATOMIC_RELEASE, "agent");
            asm volatile("s_waitcnt vmcnt(0)" ::: "memory");
            const unsigned og = xb_add(&bar[XB_TOP], 1u);
            const unsigned tg = og / nx;
            if (og + 1u == (tg + 1u) * nx) xb_add(&bar[XB_TOPGEN], 1u);
            else XB_SPIN(xb_ld(&bar[XB_TOPGEN]) == tg, bar);
            __builtin_amdgcn_fence(__ATOMIC_ACQUIRE, "agent");
            xb_add(&bar[XB_XGEN(b.x)], 1u);
            asm volatile("s_waitcnt vmcnt(0)" ::: "memory");
        } else {
            XB_SPIN(xb_ld(&bar[XB_XGEN(b.x)]) == gen, bar);
            __builtin_amdgcn_fence(__ATOMIC_ACQUIRE, "agent");
            asm volatile("s_waitcnt vmcnt(0)" ::: "memory");
        }
    }
    __syncthreads();
}

struct Frame {
    LAS unsigned char* lds;
    volatile LAS unsigned* MISC;
    gu32* ctl;
    int tid, lane, wave;
    int vcu, G;
    const float *xp, *xs, *meta, *norm_g, *w_in, *na_rpb, *sink, *wpa, *wpb, *wout, *t5, *final_g;
    float* out;
    bf16 *P, *WpT, *WoT, *U, *WinT;
    float *rpbL2, *t5L2, *sinkL2;
};

__device__ __forceinline__ float wave_sum(float v) {
#pragma unroll
    for (int o = 1; o < 64; o <<= 1) v += __shfl_xor(v, o);
    return v;
}
__device__ __forceinline__ void p0_transpose_item(const float* W, int K, int N, bf16* WT, int ldt, int row_off, int col_off, const float* gk, float sc, LAS float* scr, int item, int lane) {
    const int nblk = N / 32, kb = item / nblk, nb = item % nblk, k0 = 64 * kb, n0 = 32 * nb;
#pragma unroll 8
    for (int i = 0; i < 32; ++i) { const int kk = 2 * i + (lane >> 5); const float g = gk ? gk[k0 + kk] * sc : sc; scr[kk * 33 + (lane & 31)] = W[(size_t)(k0 + kk) * N + n0 + (lane & 31)] * g; }
    LDS_WAIT(); asm volatile("" ::: "memory");
    const int c = lane & 7;
#pragma unroll
    for (int j = 0; j < 4; ++j) { const int n = (lane >> 3) + 8 * j; const LAS float* s = scr + (8 * c) * 33 + n;
        v4u o; o.x = pk2(s[0 * 33], s[1 * 33]); o.y = pk2(s[2 * 33], s[3 * 33]); o.z = pk2(s[4 * 33], s[5 * 33]); o.w = pk2(s[6 * 33], s[7 * 33]);
        *(GAS v4u*)(WT + (size_t)(row_off + n0 + n) * ldt + col_off + k0 + 8 * c) = o; }
    LDS_WAIT(); asm volatile("" ::: "memory");
}
__device__ __forceinline__ void rms_row_to_bf16(int lane, const float* xrow, bf16* orow) {
    GAS unsigned long long* o8 = (GAS unsigned long long*)orow + lane;
    if (xrow == nullptr) {
#pragma unroll
        for (int j = 0; j < 4; ++j) o8[64 * j] = 0ull;
        return;
    }
    const GAS f32x4* xr = (const GAS f32x4*)xrow + lane;
    f32x4 v[4]; float s = 0.f;
#pragma unroll
    for (int j = 0; j < 4; ++j) { v[j] = xr[64 * j]; s += (v[j].x * v[j].x + v[j].y * v[j].y) + (v[j].z * v[j].z + v[j].w * v[j].w); }
    const float r = 1.0f / sqrtf(wave_sum(s) * (1.f / DM) + RMS_EPS);
#pragma unroll
    for (int j = 0; j < 4; ++j) o8[64 * j] = (unsigned long long)pk2(v[j].x * r, v[j].y * r) | ((unsigned long long)pk2(v[j].z * r, v[j].w * r) << 32);
}
__device__ __forceinline__ int t5_bucket(int rel) {
    const int n = rel < 0 ? -rel : rel; const int base = rel > 0 ? 16 : 0;
    if (n < 8) return base + n;
    int lg = 2 + (31 - __builtin_clz((unsigned)(n * n)));
    return base + (lg < 15 ? lg : 15);
}
__device__ __forceinline__ void p0_prologue(Frame& F) {
    LAS float* scr = (LAS float*)(F.lds + RING_OFF + F.wave * 16384);
    const int gw = F.vcu * NWAVES + F.wave, NGW = F.G * NWAVES;
    constexpr int I_IN = (DM / 64) * (NPROJ / 32), I_PA = (512 / 64) * (DM / 32), I_PB = I_PA, I_O = (DM / 64) * (DM / 32);
    constexpr int NITEMS = I_IN + I_PA + I_PB + I_O;
    for (int it = gw; it < NITEMS; it += NGW) {
        int r = it;
        if (r < I_IN) { const int n0 = 32 * (r % (NPROJ / 32)); const bool isq = (n0 < COL_KA) || (n0 >= COL_QB && n0 < COL_KB);
            p0_transpose_item(F.w_in, DM, NPROJ, F.WinT, DM, 0, 0, F.norm_g, isq ? C2 : 1.0f, scr, r, F.lane); continue; } r -= I_IN;
        if (r < I_PA) { p0_transpose_item(F.wpa, 512, DM, F.WpT, DM, 0, 0, nullptr, 1.0f, scr, r, F.lane); continue; } r -= I_PA;
        if (r < I_PB) { p0_transpose_item(F.wpb, 512, DM, F.WpT, DM, 0, 512, nullptr, 1.0f, scr, r, F.lane); continue; } r -= I_PB;
        p0_transpose_item(F.wout, DM, DM, F.WoT, DM, 0, 0, nullptr, 1.0f, scr, r, F.lane);
    }
    for (int m = gw; m < MP; m += NGW) {
        const float* src = m < N_PROMPT_ROWS ? F.xp + (size_t)m * DM : m < NTOK ? F.xs + (size_t)(m - N_PROMPT_ROWS) * DM : m < NTOK + 16 ? F.meta + (size_t)(m - NTOK) * DM : nullptr;
        rms_row_to_bf16(F.lane, src, F.U + (size_t)m * DM);
    }
    if (blockIdx.x == 0) {
        for (int i = F.tid; i < 8 * 15 * 31; i += NWAVES * 64) F.rpbL2[i] = F.na_rpb[i] * LOG2E;
        for (int i = F.tid; i < 8 * 257; i += NWAVES * 64) { const int h = i / 257, rel = i % 257 - 128; F.t5L2[i] = F.t5[t5_bucket(rel) * 8 + h] * LOG2E; }
        if (F.tid < 8) F.sinkL2[F.tid] = F.sink[F.tid] * LOG2E;
    }
}
__device__ __forceinline__ void p5_final_norm(Frame& F) {
    const int gw = F.vcu * NWAVES + F.wave, NGW = F.G * NWAVES;
    const GAS f32x4* gp = (const GAS f32x4*)F.final_g + F.lane;
    f32x4 gv[4];
#pragma unroll
    for (int j = 0; j < 4; ++j) gv[j] = gp[64 * j];
    for (int m = gw; m < NTOK; m += NGW) {
        GAS f32x4* xr = (GAS f32x4*)(F.out + (size_t)m * DM) + F.lane;
        f32x4 v[4]; float s = 0.f;
#pragma unroll
        for (int j = 0; j < 4; ++j) { v[j] = xr[64 * j]; s += (v[j].x * v[j].x + v[j].y * v[j].y) + (v[j].z * v[j].z + v[j].w * v[j].w); }
        const float r = 1.0f / sqrtf(wave_sum(s) * (1.f / DM) + RMS_EPS);
#pragma unroll
        for (int j = 0; j < 4; ++j) xr[64 * j] = v[j] * r * gv[j];
    }
}
__device__ __forceinline__ void batch_of(int t, int& tb, int& n) { if (t < N_PROMPT_ROWS) { tb = t & ~16383; n = 16384; } else { tb = N_PROMPT_ROWS + ((t - N_PROMPT_ROWS) & ~4095); n = 4096; } }
typedef short bf16x8_t __attribute__((ext_vector_type(8)));
typedef short s16x4_t __attribute__((ext_vector_type(4)));
typedef unsigned long long u64_t;
__device__ __forceinline__ f32x4 mfma16(bf16x8_t a, bf16x8_t b, f32x4 c) { return __builtin_amdgcn_mfma_f32_16x16x32_bf16(a, b, c, 0, 0, 0); }
__device__ __forceinline__ unsigned cvtpk(float lo, float hi) { typedef float f2 __attribute__((ext_vector_type(2))); typedef __bf16 b2 __attribute__((ext_vector_type(2))); f2 v = {lo, hi}; b2 b = __builtin_convertvector(v, b2); return __builtin_bit_cast(unsigned, b); }
__device__ __forceinline__ int k_off(int r, int c) { return r * 128 + ((c ^ (r & 7)) << 4); }
__device__ __forceinline__ int v_off(int r, int T, int p) { return r * 128 + ((T ^ ((r >> 1) & 3)) << 5) + 8 * p; }
__device__ __forceinline__ void k_store(LAS unsigned char* img, int r, int c, v4u w) { *(LAS v4u*)(img + k_off(r, c)) = w; }
__device__ __forceinline__ void v_store(LAS unsigned char* img, int r, int c, v4u w) {
    const int p = c >> 1, T0 = 2 * (c & 1);
    *(LAS u64_t*)(img + v_off(r, T0, p)) = (u64_t)w.x | ((u64_t)w.y << 32);
    *(LAS u64_t*)(img + v_off(r, T0 + 1, p)) = (u64_t)w.z | ((u64_t)w.w << 32);
}
__device__ __forceinline__ bf16x8_t k_frag(const LAS unsigned char* img, int row, int ks, int fq) { return *(const LAS bf16x8_t*)(img + k_off(row, 4 * ks + fq)); }
__device__ __forceinline__ s16x4_t v_tr(const LAS unsigned char* img, int row, int T, int p) {
    typedef short v4i16_t __attribute__((ext_vector_type(4)));
    return __builtin_bit_cast(s16x4_t, __builtin_amdgcn_ds_read_tr16_b64_v4i16((LAS v4i16_t*)(img + v_off(row, T, p))));
}
#define ATT_FENCE() asm volatile("s_waitcnt lgkmcnt(0)" ::: "memory")

__device__ __forceinline__ float softmax18(f32x4 (&s)[18], float extra) {
    float m = extra;
#pragma unroll
    for (int t = 0; t < 18; ++t) m = fmaxf(fmaxf(m, fmaxf(s[t][0], s[t][1])), fmaxf(s[t][2], s[t][3]));
    m = fmaxf(m, __shfl_xor(m, 16)); m = fmaxf(m, __shfl_xor(m, 32));
    float l = 0.f;
#pragma unroll
    for (int t = 0; t < 18; ++t) {
#pragma unroll
        for (int r = 0; r < 4; ++r) { const float p = __builtin_amdgcn_exp2f(s[t][r] - m); s[t][r] = p; l += p; } }
    l += __shfl_xor(l, 16); l += __shfl_xor(l, 32);
    l += __builtin_amdgcn_exp2f(extra - m);
    return 1.0f / l;
}
__device__ __forceinline__ void gate_store(bf16* zp  , const f32x4 (&o)[4], float rl) {
    GAS v4u* z4 = (GAS v4u*)zp;
#pragma unroll
    for (int hf = 0; hf < 2; ++hf) { const v4u w = z4[hf];
        const float z[8] = {bfl(w.x), bfh(w.x), bfl(w.y), bfh(w.y), bfl(w.z), bfh(w.z), bfl(w.w), bfh(w.w)}; float rr[8];
#pragma unroll
        for (int e = 0; e < 8; ++e) { const float ov = o[2 * hf + (e >> 2)][e & 3] * rl; const float sg = __builtin_amdgcn_rcpf(1.0f + __builtin_amdgcn_exp2f(-LOG2E * z[e])); rr[e] = ov * z[e] * sg; }
        v4u ov; ov.x = cvtpk(rr[0], rr[1]); ov.y = cvtpk(rr[2], rr[3]); ov.z = cvtpk(rr[4], rr[5]); ov.w = cvtpk(rr[6], rr[7]); z4[hf] = ov; }
}

__device__ __forceinline__ void na_unit(LAS unsigned char* wl, const LAS float* rpb_l, bf16* P, int tb, int rows, int i, int jg, int h, int lane) {
    const int fr = lane & 15, fq = lane >> 4;
    const int rs = min(max(i - 4, 0), rows - 8), c0 = min(max(16 * jg - 8, 0), 32);
    const int j = 16 * jg + fr, cs = min(max(j - 8, 0), 48);
    const size_t tq = (size_t)(tb + i * 64 + j);
    bf16x8_t qf[2];
#pragma unroll
    for (int ks = 0; ks < 2; ++ks) qf[ks] = *(const GAS bf16x8_t*)(P + tq * NPROJ + COL_QA + h * 64 + 32 * ks + 8 * fq);
    const int srow = lane >> 3, sc = lane & 7;
    const bf16* kv0 = P + (size_t)(tb + rs * 64 + c0 + srow) * NPROJ + h * 64 + 8 * sc;
    const bf16* kvm = P + (size_t)(META_ROW + srow) * NPROJ + h * 64 + 8 * sc;
    f32x4 s[18];
    v4u st[4], nx[4];
#define NA_LOAD(dst, a, COL) do { _Pragma("unroll") for (int it = 0; it < 4; ++it) \
        dst[it] = *(const GAS v4u*)(((a) < 8 ? kv0 + (size_t)((a) * 64 + it * 8) * NPROJ : kvm + (size_t)((it & 1) * 8) * NPROJ) + (COL)); } while (0)
    NA_LOAD(nx, 0, COL_KA);
#pragma unroll
    for (int a = 0; a < 9; ++a) {
        LAS unsigned char* kimg = wl + (a & 1) * 4096;
#pragma unroll
        for (int it = 0; it < 4; ++it) st[it] = nx[it];
        if (a < 8) NA_LOAD(nx, a + 1, COL_KA);
#pragma unroll
        for (int it = 0; it < 4; ++it) k_store(kimg, it * 8 + srow, sc, st[it]);
        ATT_FENCE();
#pragma unroll
        for (int tau = 0; tau < 2; ++tau) { f32x4 acc = {0.f, 0.f, 0.f, 0.f};
#pragma unroll
            for (int ks = 0; ks < 2; ++ks) acc = mfma16(k_frag(kimg, 16 * tau + fr, ks, fq), qf[ks], acc);
            if (a < 8) { const LAS float* brow = rpb_l + (h * 15 + (rs + a - i + 7)) * 31;
#pragma unroll
                for (int r = 0; r < 4; ++r) { const int col = c0 + 16 * tau + 4 * fq + r; const bool ok = (col >= cs) && (col <= cs + 15);
                    const int bi = min(max(col - j + 15, 0), 30); acc[r] = ok ? acc[r] + brow[bi] : -1e30f; } }
            else if (tau == 1) { acc = (f32x4){-1e30f, -1e30f, -1e30f, -1e30f}; }
            s[2 * a + tau] = acc; }
    }
    const float rl = softmax18(s, -1e30f);
    f32x4 o[4];
#pragma unroll
    for (int T = 0; T < 4; ++T) o[T] = (f32x4){0.f, 0.f, 0.f, 0.f};
    const int tg = lane >> 4, tq4 = (lane & 15) >> 2, tp = lane & 3;
    NA_LOAD(nx, 0, COL_VA);
#pragma unroll
    for (int a = 0; a < 9; ++a) {
        LAS unsigned char* vimg = wl + 8192 + (a & 1) * 4096;
#pragma unroll
        for (int it = 0; it < 4; ++it) st[it] = nx[it];
        if (a < 8) NA_LOAD(nx, a + 1, COL_VA);
#pragma unroll
        for (int it = 0; it < 4; ++it) v_store(vimg, it * 8 + srow, sc, st[it]);
        ATT_FENCE();
        v4u pw; pw.x = cvtpk(s[2 * a][0], s[2 * a][1]); pw.y = cvtpk(s[2 * a][2], s[2 * a][3]); pw.z = cvtpk(s[2 * a + 1][0], s[2 * a + 1][1]); pw.w = cvtpk(s[2 * a + 1][2], s[2 * a + 1][3]);
        const bf16x8_t pf = __builtin_bit_cast(bf16x8_t, pw);
#pragma unroll
        for (int T = 0; T < 4; ++T) { const s16x4_t lo = v_tr(vimg, 4 * tg + tq4, T, tp), hi = v_tr(vimg, 16 + 4 * tg + tq4, T, tp);
            const bf16x8_t vf = (bf16x8_t){lo[0], lo[1], lo[2], lo[3], hi[0], hi[1], hi[2], hi[3]};
            o[T] = mfma16(vf, pf, o[T]); }
    }
#undef NA_LOAD
    gate_store(P + tq * NPROJ + COL_ZA + h * 64 + 16 * fq, o, rl);
}

__device__ __forceinline__ void wa_group(const LAS unsigned char* kimg, const LAS unsigned char* vimg, const LAS float* t5_l, float sinkv, bf16* P,
                                         int t0  , int tl0  , int n, int q0, int hq, int lane) {
    const int fr = lane & 15, fq = lane >> 4, tg0 = q0 >> 4, qq = q0 + fr;
    const size_t tq = (size_t)(t0 + qq);
    bf16x8_t qf[2];
#pragma unroll
    for (int ks = 0; ks < 2; ++ks) qf[ks] = *(const GAS bf16x8_t*)(P + tq * NPROJ + COL_QB + hq * 64 + 32 * ks + 8 * fq);
    const LAS float* tb5 = t5_l + hq * 257;
    f32x4 s[18];
#pragma unroll
    for (int tau = 0; tau < 18; ++tau) { const int rbase = tau < 17 ? 16 * (tg0 + tau) : 384; f32x4 acc = {0.f, 0.f, 0.f, 0.f};
#pragma unroll
        for (int ks = 0; ks < 2; ++ks) acc = mfma16(k_frag(kimg, rbase + fr, ks, fq), qf[ks], acc);
        if (tau < 17) {
#pragma unroll
            for (int r = 0; r < 4; ++r) { const int kk = rbase + 4 * fq + r, idx = kk - qq, kl = tl0 - 128 + kk; const bool ok = (idx >= 0) && (idx <= 256) && (kl >= 0) && (kl < n);
                acc[r] = ok ? acc[r] + tb5[min(max(idx, 0), 256)] : -1e30f; } }
        else {
#pragma unroll
            for (int r = 0; r < 4; ++r) { const int mm = 4 * fq + r, nn = min(tl0 + qq + 16 - mm, 128); acc[r] += tb5[128 - nn]; } }
        s[tau] = acc; }
    const float rl = softmax18(s, sinkv);
    f32x4 o[4];
#pragma unroll
    for (int T = 0; T < 4; ++T) o[T] = (f32x4){0.f, 0.f, 0.f, 0.f};
    const int tg = lane >> 4, tq4 = (lane & 15) >> 2, tp = lane & 3;
#pragma unroll
    for (int ksx = 0; ksx < 9; ++ksx) {
        const int r0 = 16 * (tg0 + 2 * ksx), r1 = ksx < 8 ? r0 + 16 : 384;
        v4u pw; pw.x = cvtpk(s[2 * ksx][0], s[2 * ksx][1]); pw.y = cvtpk(s[2 * ksx][2], s[2 * ksx][3]); pw.z = cvtpk(s[2 * ksx + 1][0], s[2 * ksx + 1][1]); pw.w = cvtpk(s[2 * ksx + 1][2], s[2 * ksx + 1][3]);
        const bf16x8_t pf = __builtin_bit_cast(bf16x8_t, pw);
#pragma unroll
        for (int T = 0; T < 4; ++T) { const s16x4_t lo = v_tr(vimg, r0 + 4 * tg + tq4, T, tp), hi = v_tr(vimg, r1 + 4 * tg + tq4, T, tp);
            const bf16x8_t vf = (bf16x8_t){lo[0], lo[1], lo[2], lo[3], hi[0], hi[1], hi[2], hi[3]};
            o[T] = mfma16(vf, pf, o[T]); }
    }
    gate_store(P + tq * NPROJ + COL_ZB + hq * 64 + 16 * fq, o, rl);
}

constexpr int TAB_LDS_OFF = 132096, TAB_LDS_T5 = TAB_LDS_OFF + 16384;
__device__ __forceinline__ void p2_attention(Frame& F) {
    LAS float* rpb_l = (LAS float*)(F.lds + TAB_LDS_OFF); LAS float* t5_l = (LAS float*)(F.lds + TAB_LDS_T5);
    for (int u = F.tid; u < 8 * 15 * 31; u += NWAVES * 64) rpb_l[u] = F.rpbL2[u];
    for (int u = F.tid; u < 8 * 257; u += NWAVES * 64) t5_l[u] = F.t5L2[u];
    __syncthreads();
    if (F.G == 256) {
        const int x = F.vcu >> 5, w = F.vcu & 31, jg = w & 3, rofs = w >> 2;
        LAS unsigned char* wl = F.lds + RING_OFF + F.wave * 16384;
        for (int sstep = 0; sstep < 24; ++sstep) {
            const int rid = 192 * x + 8 * sstep + rofs; int tb, rows, i;
            if (rid < 512) { tb = (rid >> 8) * 16384; rows = 256; i = rid & 255; } else { const int r2 = rid - 512; tb = N_PROMPT_ROWS + (r2 >> 6) * 4096; rows = 64; i = r2 & 63; }
            na_unit(wl, rpb_l, F.P, tb, rows, i, jg, F.wave, F.lane);
        }
    }
    __syncthreads();
    {
        LAS unsigned char* kimg = F.lds + RING_OFF; LAS unsigned char* vimg = F.lds + RING_OFF + 51200;
        for (int uidx = F.vcu; uidx < 1536; uidx += F.G) {
            const int blk = uidx >> 1, kh = uidx & 1; const int t0 = blk * 128; int tb, n; batch_of(t0, tb, n); const int tl0 = t0 - tb;
            for (int idx = F.tid; idx < 400 * 8; idx += NWAVES * 64) { const int row = idx >> 3, c = idx & 7; v4u kw = {0u, 0u, 0u, 0u}, vw = {0u, 0u, 0u, 0u};
                int src = -1; if (row < 384) { const int kl = tl0 - 128 + row; if (kl >= 0 && kl < n) src = tb + kl; } else src = META_ROW + (row - 384);
                if (src >= 0) { const bf16* rp = F.P + (size_t)src * NPROJ + kh * 64 + 8 * c; kw = *(const GAS v4u*)(rp + COL_KB); vw = *(const GAS v4u*)(rp + COL_VB); }
                k_store(kimg, row, c, kw); v_store(vimg, row, c, vw); }
            __syncthreads();
            const int g = F.wave >> 1, hq = 4 * kh + g; const float sinkv = F.sinkL2[hq];
            for (int gi = 0; gi < 4; ++gi) wa_group(kimg, vimg, t5_l, sinkv, F.P, t0, tl0, n, 16 * ((F.wave & 1) * 4 + gi), hq, F.lane);
            __syncthreads();
        }
    }
}
struct Args { const float* in[12]; float* out; unsigned char* ws; int ph_lo, ph_hi, li, pad; };
__global__ void __launch_bounds__(NWAVES * 64, 2) mk_fwd(Args args) {
    extern __shared__ __attribute__((aligned(16))) unsigned char lds[];
    Frame F;
    F.lds = (LAS unsigned char*)lds;
    F.MISC = (volatile LAS unsigned*)(F.lds + MISC_OFF);
    F.tid = threadIdx.x; F.lane = F.tid & 63; F.wave = __builtin_amdgcn_readfirstlane(F.tid >> 6);
    F.G = gridDim.x; { const int bx = blockIdx.x; F.vcu = (F.G % 8 == 0) ? (bx % 8) * (F.G / 8) + bx / 8 : bx; }
    unsigned char* ws = args.ws;
    F.ctl = (gu32*)(ws + WS_CTL);
    F.xp = args.in[0]; F.xs = args.in[1]; F.meta = args.in[2]; F.norm_g = args.in[3]; F.w_in = args.in[4]; F.na_rpb = args.in[5]; F.sink = args.in[6];
    F.wpa = args.in[7]; F.wpb = args.in[8]; F.wout = args.in[9]; F.t5 = args.in[10]; F.final_g = args.in[11]; F.out = args.out;
    F.P = (bf16*)(ws + WS_P); F.WpT = (bf16*)(ws + WS_WP); F.WoT = (bf16*)(ws + WS_WO);
    F.U = (bf16*)((unsigned char*)args.out + DO_U); F.WinT = (bf16*)((unsigned char*)args.out + DO_WIN);
    F.rpbL2 = (float*)(ws + WS_TAB + TAB_RPB); F.t5L2 = (float*)(ws + WS_TAB + TAB_T5); F.sinkL2 = (float*)(ws + WS_TAB + TAB_SINK);
    for (int u = F.tid; u < (LDS_BYTES - LDSCTL_OFF) / 4; u += NWAVES * 64) ((LAS unsigned*)(F.lds + LDSCTL_OFF))[u] = 0u;
    __syncthreads();
    XcdBarrier bar; bar.bar = (unsigned*)(F.ctl + CW_BAR); bar.x = 0; bar.st = nullptr;
    if (N_LAUNCHES != PER_PHASE) bar = xcd_barrier_post((unsigned*)(F.ctl + CW_BAR), F.MISC + 8);
#define GRID_BAR() do { if (N_LAUNCHES != PER_PHASE) xcd_barrier(bar); } while (0)
    const int lo = args.ph_lo, hi = args.ph_hi;
#define IN(k) (lo <= (k) && (k) < hi)
#define BOTH(k) (IN(k) && IN((k) + 1))
    if (IN(0)) { p0_prologue(F); if (BOTH(0)) GRID_BAR(); }
    if (IN(1)) {
        pg8::Gemm g{F.U, F.WinT, MP, NPROJ, DM, DM, DM}; pg8::StaticOrder S; S.init(MP, NPROJ, F.G, (int)blockIdx.x);
        pg8::EpiStoreBf16 E{F.P, NPROJ};
        pg8::gemm_phase<pg8::EpiStoreBf16, pg8::StaticOrder, PG8_ALIGN, PG8_SP2>(F.lds + RING_OFF, g, S, E);
        if (BOTH(1)) GRID_BAR();
    }
    if (IN(2)) {
        p2_attention(F);
        if (BOTH(2)) GRID_BAR();
    }
    if (IN(3)) {
        { pg8::Gemm g{F.P + COL_ZA, F.WpT, NTOK, DM, 512, NPROJ, DM}; pg8::StaticOrder S; S.init(NTOK, DM, F.G, (int)blockIdx.x);
          pg8::EpiGate<false> E{F.P, NPROJ, COL_GA};
          pg8::gemm_phase<pg8::EpiGate<false>, pg8::StaticOrder, PG8_ALIGN, PG8_SP2>(F.lds + RING_OFF, g, S, E); }
        { pg8::Gemm g{F.P + COL_ZB, F.WpT + 512, NTOK, DM, 512, NPROJ, DM}; pg8::StaticOrder S; S.init(NTOK, DM, F.G, (int)blockIdx.x);
          pg8::EpiGate<true> E{F.P, NPROJ, COL_GB};
          pg8::gemm_phase<pg8::EpiGate<true>, pg8::StaticOrder, PG8_ALIGN, PG8_SP2>(F.lds + RING_OFF, g, S, E); }
        if (BOTH(3)) GRID_BAR();
    }
    if (IN(4)) {
        pg8::Gemm g{F.P, F.WoT, NTOK, DM, DM, NPROJ, DM}; pg8::StaticOrder S; S.init(NTOK, DM, F.G, (int)blockIdx.x);
        pg8::EpiResF32 E{F.xp, F.xs, N_PROMPT_ROWS, F.out, DM};
        pg8::gemm_phase<pg8::EpiResF32, pg8::StaticOrder, PG8_ALIGN, PG8_SP2>(F.lds + RING_OFF, g, S, E);
        if (BOTH(4)) GRID_BAR();
    }
    if (IN(5)) { p5_final_norm(F); }
#undef IN
#undef BOTH
}

extern "C" void kernel_launch(void* const* d_in, const int* in_sizes, int n_in, void* d_out, int out_size, void* d_ws, size_t ws_size, hipStream_t stream) {
    static int grid = 0;
    if (grid == 0) {
        if (n_in != 12 || out_size != NTOK * DM || ws_size < WS_END) { fprintf(stderr, "kernel_launch: unexpected shapes: n_in %d out %d ws %zu (need %zu)\n", n_in, out_size, ws_size, (size_t)WS_END); grid = -1; return; }
        int dev = 0, cus = 0;
        if (hipGetDevice(&dev) != hipSuccess || hipDeviceGetAttribute(&cus, hipDeviceAttributeMultiprocessorCount, dev) != hipSuccess) { grid = -1; return; }
        if (hipFuncSetAttribute((const void*)mk_fwd, hipFuncAttributeMaxDynamicSharedMemorySize, LDS_BYTES) != hipSuccess) { fprintf(stderr, "kernel_launch: hipFuncSetAttribute failed\n"); grid = -1; return; }
        (void)hipGetLastError();
        grid = cus;
    }
    if (grid < 0) return;
    (void)hipMemsetAsync((char*)d_ws + WS_CTL, 0, CTL_ZERO_BYTES, stream);
    Args a{};
    for (int i = 0; i < 12; ++i) a.in[i] = (const float*)d_in[i];
    a.out = (float*)d_out; a.ws = (unsigned char*)d_ws;
    for (int li = 0; li < N_LAUNCHES; ++li) {
        a.ph_lo = (N_LAUNCHES == PER_PHASE) ? li : 0; a.ph_hi = (N_LAUNCHES == PER_PHASE) ? li + 1 : PER_PHASE; a.li = li;
        hipLaunchKernelGGL(mk_fwd, dim3(grid), dim3(NWAVES * 64), LDS_BYTES, stream, a);
    }
}
```

```cpp
#define MK_N_LAUNCHES 1
#include <hip/hip_runtime.h>
#include <cstdio>
#include <cstdint>
namespace pg8 {
#define PG8_LAS __attribute__((address_space(3)))
typedef unsigned short bf16_t;
typedef short bf16x8 __attribute__((ext_vector_type(8)));
typedef float f32x4 __attribute__((ext_vector_type(4)));
typedef unsigned u32x4 __attribute__((ext_vector_type(4)));
typedef int v4i_t __attribute__((ext_vector_type(4)));
typedef int v8i_t __attribute__((ext_vector_type(8)));
constexpr int BM = 256, BK = 64, HALF = 128, HTB = HALF * BK * 2  , STAGE_BYTES = 8 * HTB, NXCD = 8, WGM = 8;

__host__ __device__ __forceinline__ int lds_byte(int r, int c) { const int st = (r >> 4) * 2 + (c >> 5), rr = r & 15, cc = c & 31, ob = rr * 64 + cc * 2; return st * 1024 + (ob ^ (((ob >> 9) & 1) << 5)); }
__host__ __device__ __forceinline__ void stage_rc(int b, int& R, int& C) { const int st = b / 1024, sb = b % 1024, swz = sb ^ (((sb >> 9) & 1) << 5); R = (st >> 1) * 16 + swz / 64; C = (st & 1) * 32 + (swz % 64) / 2; }
__host__ __device__ __forceinline__ int perm32(int rho) { const int n = rho >> 4, i = rho & 15; return 8 * (i >> 2) + 4 * n + (i & 3); }

struct Unit { int pm, pn; };
struct Gemm { const bf16_t* A; const bf16_t* Bt; int M, N, K, lda, ldb; size_t kstepA; };

struct StaticOrder {
    int nM, nN, nwg, G, c, wgm;
    __host__ __device__ void init(int M, int N, int G_, int c_, int wgm_ = WGM) { nM = M / BM; nN = N / BM; nwg = nM * nN; G = G_; c = c_; wgm = wgm_; }
    __host__ __device__ bool next(int i, Unit& u) const {
        const long L = (long)i * G + c; if (L >= nwg) return false;
        int wgid = (int)L; { const int q = nwg / NXCD, r = nwg % NXCD, xcd = wgid % NXCD, off = wgid / NXCD; wgid = (xcd < r ? xcd * (q + 1) : r * (q + 1) + (xcd - r) * q) + off; }
        const int nig = wgm * nN, gid = wgid / nig, fm = gid * wgm, gsz = (nM - fm) < wgm ? (nM - fm) : wgm;
        u.pm = fm + ((wgid % nig) % gsz); u.pn = (wgid % nig) / gsz; return true;
    }
    __device__ __forceinline__ void a_ready(const Unit&) const {}
    __device__ __forceinline__ void done(const Unit&) const {}
};

__device__ __forceinline__ unsigned cvt_pk_bf16(float lo, float hi) { unsigned r; asm volatile("v_cvt_pk_bf16_f32 %0, %1, %2" : "=v"(r) : "v"(lo), "v"(hi)); return r; }
template <bool MAXABS> struct PanelStat {
    unsigned* xbuf;
    unsigned* cnt;
    unsigned* tmo;
    PG8_LAS unsigned char* aux;
    __device__ __forceinline__ void run(const f32x4 (&v)[2][2][4][2], const Unit& u, int wr, int wc, int fr, int fq, int wid, int lane) const {
        PG8_LAS float* Pt = (PG8_LAS float*)aux;
        PG8_LAS float* S = (PG8_LAS float*)(aux + 4096);
        PG8_LAS unsigned* flag = (PG8_LAS unsigned*)(aux + 4096 + 1024);
#pragma unroll
        for (int ai = 0; ai < 2; ++ai)
#pragma unroll
            for (int m = 0; m < 4; ++m) { float q = 0.f;
#pragma unroll
                for (int bj = 0; bj < 2; ++bj)
#pragma unroll
                    for (int n = 0; n < 2; ++n) { const f32x4 d = v[ai][bj][m][n];
                        if (MAXABS) q = fmaxf(q, fmaxf(fmaxf(fabsf(d[0]), fabsf(d[1])), fmaxf(fabsf(d[2]), fabsf(d[3])))); else q += (d[0] * d[0] + d[1] * d[1]) + (d[2] * d[2] + d[3] * d[3]); }
                if (MAXABS) { q = fmaxf(q, __shfl_xor(q, 16)); q = fmaxf(q, __shfl_xor(q, 32)); } else { q += __shfl_xor(q, 16); q += __shfl_xor(q, 32); }
                if (fq == 0) Pt[(ai * HALF + wr * 64 + m * 16 + fr) * 4 + wc] = q; }
        asm volatile("s_waitcnt lgkmcnt(0)" ::: "memory"); __builtin_amdgcn_s_barrier(); asm volatile("" ::: "memory");
        const int row = wid * 32 + (lane & 31);
        unsigned long long* slot0 = (unsigned long long*)xbuf + (size_t)(u.pm * BM + row) * 4;
        if (lane < 32) { const float q = MAXABS ? fmaxf(fmaxf(Pt[row * 4 + 0], Pt[row * 4 + 1]), fmaxf(Pt[row * 4 + 2], Pt[row * 4 + 3])) : (Pt[row * 4 + 0] + Pt[row * 4 + 1]) + (Pt[row * 4 + 2] + Pt[row * 4 + 3]);
            __hip_atomic_store(slot0 + u.pn, (1ull << 32) | (unsigned long long)__float_as_uint(q), __ATOMIC_RELAXED, __HIP_MEMORY_SCOPE_AGENT); }
        { float q = 0.f;
          for (int it = 0;; ++it) {
              bool ok = true; q = 0.f;
              if (lane < 32) {
#pragma unroll
                  for (int t = 0; t < 4; ++t) { const unsigned long long x = __hip_atomic_load(slot0 + t, __ATOMIC_RELAXED, __HIP_MEMORY_SCOPE_AGENT); ok = ok && ((x >> 32) != 0);
                      const float a = __uint_as_float((unsigned)x); q = MAXABS ? fmaxf(q, a) : q + a; } }
              if (__all(ok)) break;
              if (it > 400000) { if (lane == 0) __hip_atomic_store(tmo, 1u, __ATOMIC_RELAXED, __HIP_MEMORY_SCOPE_AGENT); break; }
              __builtin_amdgcn_s_sleep(1); }
          if (lane < 32) S[row] = MAXABS ? q : 1.0f / sqrtf(q * (1.0f / 1024.0f) + 1e-6f); }
        asm volatile("s_waitcnt vmcnt(0) lgkmcnt(0)" ::: "memory"); __builtin_amdgcn_s_barrier(); asm volatile("" ::: "memory");
    }
};
__device__ __forceinline__ float bf_lo(unsigned w) { return __uint_as_float(w << 16); }
__device__ __forceinline__ float bf_hi(unsigned w) { return __uint_as_float(w & 0xffff0000u); }
typedef float f32x2_t __attribute__((ext_vector_type(2)));
__device__ __forceinline__ void fp8x8_to_f32(unsigned lo, unsigned hi, float (&o)[8]) {
    const f32x2_t a = __builtin_amdgcn_cvt_pk_f32_fp8((int)lo, false), b = __builtin_amdgcn_cvt_pk_f32_fp8((int)lo, true), c = __builtin_amdgcn_cvt_pk_f32_fp8((int)hi, false), d = __builtin_amdgcn_cvt_pk_f32_fp8((int)hi, true);
    o[0] = a.x; o[1] = a.y; o[2] = b.x; o[3] = b.y; o[4] = c.x; o[5] = c.y; o[6] = d.x; o[7] = d.y;
}
__device__ __forceinline__ float sigmoidf_fast(float g) { return __builtin_amdgcn_rcpf(1.0f + __builtin_amdgcn_exp2f(-1.4426950408889634f * g)); }
struct EpiI8 {
    static constexpr bool PERM = true, AFTER_DRAIN = false, INLOOP = false, HAS_MID = false;
    bf16_t* HM; bf16_t* G; const float* su; const float* sw; int mp;
    __device__ __forceinline__ void operator()(const f32x4 (&acc)[2][2][4][2], const Unit& u, int wr, int wc, int fr, int fq) const {
        const int row0 = u.pm * BM + wr * 64 + fr; const int col0 = u.pn * BM + wc * 32 + 8 * fq; const bool hm = (u.pn < 13);
        f32x4 cw[2][2];
#pragma unroll
        for (int bj = 0; bj < 2; ++bj)
#pragma unroll
            for (int n = 0; n < 2; ++n) cw[bj][n] = *(const f32x4*)(sw + col0 + bj * HALF + 4 * n);
        float rsv[2][4];
#pragma unroll
        for (int ai = 0; ai < 2; ++ai)
#pragma unroll
            for (int m = 0; m < 4; ++m) rsv[ai][m] = su[row0 + ai * HALF + m * 16];
#pragma unroll
        for (int ai = 0; ai < 2; ++ai)
#pragma unroll
            for (int m = 0; m < 4; ++m) { const int row = row0 + ai * HALF + m * 16; const float rs = rsv[ai][m];
#pragma unroll
                for (int bj = 0; bj < 2; ++bj) { const int col = col0 + bj * HALF;
                    const v4i_t i0 = __builtin_bit_cast(v4i_t, acc[ai][bj][m][0]), i1 = __builtin_bit_cast(v4i_t, acc[ai][bj][m][1]);
                    const f32x4 v0 = (f32x4){(float)i0[0], (float)i0[1], (float)i0[2], (float)i0[3]} * cw[bj][0] * rs, v1 = (f32x4){(float)i1[0], (float)i1[1], (float)i1[2], (float)i1[3]} * cw[bj][1] * rs;
                    if (hm) { u32x4 w; w.x = cvt_pk_bf16(v0[0], v0[1]); w.y = cvt_pk_bf16(v0[2], v0[3]); w.z = cvt_pk_bf16(v1[0], v1[1]); w.w = cvt_pk_bf16(v1[2], v1[3]);
                        *(u32x4*)(HM + ((size_t)(col >> 6) * mp + row) * 64 + (col & 63)) = w; }
                    else { int lo = __builtin_amdgcn_cvt_pk_fp8_f32(v0[0], v0[1], 0, false); lo = __builtin_amdgcn_cvt_pk_fp8_f32(v0[2], v0[3], lo, true);
                        int hi = __builtin_amdgcn_cvt_pk_fp8_f32(v1[0], v1[1], 0, false); hi = __builtin_amdgcn_cvt_pk_fp8_f32(v1[2], v1[3], hi, true);
                        *(unsigned long long*)((unsigned char*)G + (size_t)row * 2048 + (col - 3328)) = (unsigned long long)(unsigned)lo | ((unsigned long long)(unsigned)hi << 32); } } }
    }
};
struct EpiGate2 {
    static constexpr bool PERM = true, AFTER_DRAIN = false, INLOOP = true, HAS_MID = true;
    bf16_t* HM; const bf16_t* G; int mp; float oscale; PanelStat<true> st; float* su2;
    __device__ __forceinline__ void mid(f32x4 (&acc)[2][2][4][2], const Unit& u, int wr, int wc, int fr, int fq) const {
        const int row0 = u.pm * BM + wr * 64 + fr; const int col0 = u.pn * BM + wc * 32 + 8 * fq;
        const unsigned char* gr = (const unsigned char*)G + (size_t)row0 * 2048 + col0;
        unsigned long long ga[2][4][2], gb[2][4][2];
#define EG2_LOAD(ai_, m_) do { _Pragma("unroll") for (int bj = 0; bj < 2; ++bj) { ga[ai_][m_][bj] = *(const unsigned long long*)(gr + (size_t)((ai_) * HALF + (m_) * 16) * 2048 + bj * HALF); \
            gb[ai_][m_][bj] = *(const unsigned long long*)(gr + (size_t)((ai_) * HALF + (m_) * 16) * 2048 + 1024 + bj * HALF); } } while (0)
#define EG2_MATH(ai_, m_) do { _Pragma("unroll") for (int bj = 0; bj < 2; ++bj) { float a[8], b[8]; fp8x8_to_f32((unsigned)ga[ai_][m_][bj], (unsigned)(ga[ai_][m_][bj] >> 32), a); fp8x8_to_f32((unsigned)gb[ai_][m_][bj], (unsigned)(gb[ai_][m_][bj] >> 32), b); \
            _Pragma("unroll") for (int e = 0; e < 8; ++e) { const float ea = __builtin_amdgcn_exp2f(-1.4426950408889634f * a[e]), eb = __builtin_amdgcn_exp2f(-1.4426950408889634f * b[e]); \
                acc[ai_][bj][m_][e >> 2][e & 3] *= (1.0f + eb) * __builtin_amdgcn_rcpf(1.0f + ea); }        \
            asm volatile("" : "+v"(acc[ai_][bj][m_][0]), "+v"(acc[ai_][bj][m_][1])); } } while (0)
        asm volatile("" : "+v"(gr));
        EG2_LOAD(0, 0); EG2_LOAD(0, 1); EG2_LOAD(0, 2); EG2_LOAD(0, 3); EG2_LOAD(1, 0); EG2_LOAD(1, 1);
        asm volatile("" ::: "memory");
        EG2_MATH(0, 0); EG2_MATH(0, 1);
        asm volatile("" : "+v"(gr) :: "memory");
        EG2_LOAD(1, 2); EG2_LOAD(1, 3);
        asm volatile("" ::: "memory");
        EG2_MATH(0, 2); EG2_MATH(0, 3); EG2_MATH(1, 0); EG2_MATH(1, 1); EG2_MATH(1, 2); EG2_MATH(1, 3);
        asm volatile("" ::: "memory");
#undef EG2_LOAD
#undef EG2_MATH
    }
    __device__ __forceinline__ void fused(f32x4 (&acc)[2][2][4][2], const Unit& u, int wr, int wc, int fr, int fq, int wid, int lane) const {
        const int row0 = u.pm * BM + wr * 64 + fr; const int col0 = u.pn * BM + wc * 32 + 8 * fq;
        const unsigned char* gr = (const unsigned char*)G + (size_t)row0 * 2048 + 1024 + col0;
        unsigned long long gb[2][4][2];
#pragma unroll
        for (int ai = 0; ai < 2; ++ai) { asm volatile("" : "+v"(gr));
#pragma unroll
            for (int m = 0; m < 4; ++m)
#pragma unroll
                for (int bj = 0; bj < 2; ++bj) gb[ai][m][bj] = *(const unsigned long long*)(gr + (size_t)m * 16 * 2048 + bj * HALF);
            gr += (size_t)HALF * 2048; }
#pragma unroll
        for (int ai = 0; ai < 2; ++ai) {
#pragma unroll
            for (int m = 0; m < 4; ++m)
#pragma unroll
                for (int bj = 0; bj < 2; ++bj) { float g8[8]; fp8x8_to_f32((unsigned)gb[ai][m][bj], (unsigned)(gb[ai][m][bj] >> 32), g8);
#pragma unroll
                    for (int e = 0; e < 8; ++e) acc[ai][bj][m][e >> 2][e & 3] *= oscale * sigmoidf_fast(g8[e]);
                    asm volatile("" : "+v"(acc[ai][bj][m][0]), "+v"(acc[ai][bj][m][1])); }
            asm volatile("" ::: "memory"); }
        st.run(acc, u, wr, wc, fr, fq, wid, lane);
        const PG8_LAS float* S = (const PG8_LAS float*)(st.aux + 4096);
#pragma unroll
        for (int ai = 0; ai < 2; ++ai)
#pragma unroll
            for (int m = 0; m < 4; ++m) { const int rl = ai * HALF + wr * 64 + m * 16 + fr, row = u.pm * BM + rl; const float mx = S[rl], inv = mx > 0.f ? 127.0f / mx : 0.f;
                if (u.pn == 0 && wc == 0 && fq == 0) su2[row] = mx * (1.0f / 127.0f);
#pragma unroll
                for (int bj = 0; bj < 2; ++bj) { const f32x4 v0 = acc[ai][bj][m][0] * inv, v1 = acc[ai][bj][m][1] * inv; const int col = col0 + bj * HALF;
                    unsigned char* dst = (unsigned char*)HM + ((size_t)(col >> 7) * mp + row) * 128 + (col & 127);
                    const int i0 = __float2int_rn(v0[0]), i1 = __float2int_rn(v0[1]), i2 = __float2int_rn(v0[2]), i3 = __float2int_rn(v0[3]), i4 = __float2int_rn(v1[0]), i5 = __float2int_rn(v1[1]), i6 = __float2int_rn(v1[2]), i7 = __float2int_rn(v1[3]);
                    const unsigned lo = (unsigned)(i0 & 0xff) | ((unsigned)(i1 & 0xff) << 8) | ((unsigned)(i2 & 0xff) << 16) | ((unsigned)(i3 & 0xff) << 24), hi = (unsigned)(i4 & 0xff) | ((unsigned)(i5 & 0xff) << 8) | ((unsigned)(i6 & 0xff) << 16) | ((unsigned)(i7 & 0xff) << 24);
                    *(unsigned long long*)dst = (unsigned long long)lo | ((unsigned long long)hi << 32); } }
    }
};
struct EpiResNorm {
    static constexpr bool PERM = false, AFTER_DRAIN = false, INLOOP = true, HAS_MID = false;
    const float* xa; const float* xb; int nsplit; const float* gam; float* out; int ldc; PanelStat<false> st; const float* sa; const float* sb;
    __device__ __forceinline__ void fused(f32x4 (&acc)[2][2][4][2], const Unit& u, int wr, int wc, int fr, int fq, int wid, int lane) const {
        const int row0 = u.pm * BM + wr * 64 + fr, col0 = u.pn * BM + wc * 32 + 4 * fq;
#pragma unroll
        for (int ai = 0; ai < 2; ++ai)
#pragma unroll
            for (int m = 0; m < 4; ++m) { const int row = row0 + ai * HALF + m * 16; const float rs = sa[row];
                const float* xr = (row < nsplit ? xa + (size_t)row * ldc : xb + (size_t)(row - nsplit) * ldc) + col0;
#pragma unroll
                for (int bj = 0; bj < 2; ++bj)
#pragma unroll
                    for (int n = 0; n < 2; ++n) { const v4i_t iv = __builtin_bit_cast(v4i_t, acc[ai][bj][m][n]); const f32x4 cs = *(const f32x4*)(sb + col0 + bj * HALF + n * 16);
                        acc[ai][bj][m][n] = (f32x4){(float)iv[0], (float)iv[1], (float)iv[2], (float)iv[3]} * cs * rs + *(const f32x4*)(xr + bj * HALF + n * 16); }
                asm volatile("" : "+v"(acc[ai][0][m][0]), "+v"(acc[ai][0][m][1]), "+v"(acc[ai][1][m][0]), "+v"(acc[ai][1][m][1]));
                if (m == 3) asm volatile("" ::: "memory"); }
        st.run(acc, u, wr, wc, fr, fq, wid, lane);
        const PG8_LAS float* S = (const PG8_LAS float*)(st.aux + 4096);
        f32x4 gv[2][2];
#pragma unroll
        for (int bj = 0; bj < 2; ++bj)
#pragma unroll
            for (int n = 0; n < 2; ++n) gv[bj][n] = *(const f32x4*)(gam + col0 + bj * HALF + n * 16);
#pragma unroll
        for (int ai = 0; ai < 2; ++ai)
#pragma unroll
            for (int m = 0; m < 4; ++m) { const int rl = ai * HALF + wr * 64 + m * 16 + fr; const float rs = S[rl]; float* rowp = out + (size_t)(u.pm * BM + rl) * ldc + col0;
#pragma unroll
                for (int bj = 0; bj < 2; ++bj)
#pragma unroll
                    for (int n = 0; n < 2; ++n) *(f32x4*)(rowp + bj * HALF + n * 16) = acc[ai][bj][m][n] * rs * gv[bj][n]; }
    }
};
__device__ __forceinline__ f32x4 mma_f8(bf16x8 x0, bf16x8 x1, bf16x8 y0, bf16x8 y1, f32x4 c) {
    const v4i_t xa = __builtin_bit_cast(v4i_t, x0), xb = __builtin_bit_cast(v4i_t, x1), ya = __builtin_bit_cast(v4i_t, y0), yb = __builtin_bit_cast(v4i_t, y1);
    const v8i_t x = {xa[0], xa[1], xa[2], xa[3], xb[0], xb[1], xb[2], xb[3]}, y = {ya[0], ya[1], ya[2], ya[3], yb[0], yb[1], yb[2], yb[3]};
    const int sc = 0x7F7F7F7F;
    asm volatile("s_nop 1\n\tv_mfma_scale_f32_16x16x128_f8f6f4 %0, %1, %2, %0, %3, %3 op_sel_hi:[0,0,0]" : "+v"(c) : "v"(x), "v"(y), "v"(sc));
    return c;
}
template <class Epi, class Sched, bool ALIGN_EPI = false, bool SP2 = false, int F8 = 0>
__device__ __forceinline__ void gemm_phase(PG8_LAS unsigned char* lds, const Gemm g, const Sched& S, const Epi& E, const int wid  ) {
    const int lane = (int)__builtin_amdgcn_mbcnt_hi(~0u, __builtin_amdgcn_mbcnt_lo(~0u, 0u)), tid = wid * 64 + lane, wr = wid >> 2, wc = wid & 3, fr = lane & 15, fq = lane >> 4;
    const int K = g.K, nt = K / BK;
    unsigned voffA[2], voffB[2];
#pragma unroll
    for (int i = 0; i < 2; ++i) { int R, C; stage_rc(tid * 16 + i * 8192, R, C); const int Rb = Epi::PERM ? ((R & ~31) + perm32(R & 31)) : R;
        voffA[i] = (unsigned)(R * g.lda + C) * 2u; voffB[i] = (unsigned)(Rb * g.ldb + C) * 2u; }
    const size_t kstepA = g.kstepA, kstepB = (size_t)(BK * 2);
    const size_t hstepA = (size_t)HALF * g.lda * 2, hstepB = (size_t)HALF * g.ldb * 2;
    const size_t tstepA = 2 * hstepA, tstepB = 2 * hstepB;
    const unsigned ldsw = (unsigned)wid * 1024u;
    const int aoff = lds_byte(wr * 64 + fr, fq * 8), boff = lds_byte(wc * 32 + fr, fq * 8);
#define PG8_SA(b, h) (((b) * 2 + (h)) * HTB)
#define PG8_SB(b, h) ((4 + (b) * 2 + (h)) * HTB)
#define PG8_STAGE(bufoff, gbase, voff) do { _Pragma("unroll") for (int _i = 0; _i < 2; ++_i) \
        __builtin_amdgcn_global_load_lds((const unsigned*)((const char*)(gbase) + (voff)[_i]), (PG8_LAS unsigned*)(lds + (bufoff) + ldsw + _i * 8192), 16, 0, 0); } while (0)
#define PG8_LDA(dst, b, h) do { _Pragma("unroll") for (int m = 0; m < 4; ++m) _Pragma("unroll") for (int k = 0; k < 2; ++k) dst[m][k] = *(const PG8_LAS bf16x8*)(lds + PG8_SA(b, h) + aoff + m * 2048 + k * 1024); } while (0)
#define PG8_LDB(dst, b, h) do { _Pragma("unroll") for (int n = 0; n < 2; ++n) _Pragma("unroll") for (int k = 0; k < 2; ++k) dst[n][k] = *(const PG8_LAS bf16x8*)(lds + PG8_SB(b, h) + boff + n * 2048 + k * 1024); } while (0)
#define PG8_MMA(ai, bj, At, Bt) do { __builtin_amdgcn_s_setprio(1); \
        if constexpr (F8 == 2) { _Pragma("unroll") for (int m = 0; m < 4; ++m) _Pragma("unroll") for (int n = 0; n < 2; ++n) _Pragma("unroll") for (int k = 0; k < 2; ++k) \
            acc[ai][bj][m][n] = __builtin_bit_cast(f32x4, __builtin_amdgcn_mfma_i32_16x16x64_i8(__builtin_bit_cast(v4i_t, Bt[n][k]), __builtin_bit_cast(v4i_t, At[m][k]), __builtin_bit_cast(v4i_t, acc[ai][bj][m][n]), 0, 0, 0)); } \
        else if constexpr (F8 == 1) { __builtin_amdgcn_sched_barrier(0); _Pragma("unroll") for (int m = 0; m < 4; ++m) _Pragma("unroll") for (int n = 0; n < 2; ++n) acc[ai][bj][m][n] = mma_f8(Bt[n][0], Bt[n][1], At[m][0], At[m][1], acc[ai][bj][m][n]); \
            __builtin_amdgcn_sched_barrier(0); }     \
        else { _Pragma("unroll") for (int m = 0; m < 4; ++m) _Pragma("unroll") for (int n = 0; n < 2; ++n) _Pragma("unroll") for (int k = 0; k < 2; ++k) \
            acc[ai][bj][m][n] = __builtin_amdgcn_mfma_f32_16x16x32_bf16(Bt[n][k], At[m][k], acc[ai][bj][m][n], 0, 0, 0); } \
        __builtin_amdgcn_s_setprio(0); } while (0)
#define PG8_WAIT_V(n) asm volatile("s_waitcnt vmcnt(" #n ")" ::: "memory")
#define PG8_WAIT_L(n) asm volatile("s_waitcnt lgkmcnt(" #n ")" ::: "memory")
#define PG8_BAR __builtin_amdgcn_s_barrier()
#define PG8_SCHED __builtin_amdgcn_sched_barrier(0)
    Unit cur, nxt; int ui = 0;
    if (!S.next(0, cur)) return;
    f32x4 acc[2][2][4][2];
#pragma unroll
    for (int a = 0; a < 2; ++a)
#pragma unroll
        for (int b = 0; b < 2; ++b)
#pragma unroll
            for (int m = 0; m < 4; ++m)
#pragma unroll
                for (int n = 0; n < 2; ++n) acc[a][b][m][n] = (f32x4){0.f, 0.f, 0.f, 0.f};
    bf16x8 At[4][2], B0[2][2], B1[2][2];
    const char* cA = (const char*)g.A + (size_t)cur.pm * tstepA; const char* cB = (const char*)g.Bt + (size_t)cur.pn * tstepB;
    S.a_ready(cur);
    if constexpr (SP2) {
        PG8_STAGE(PG8_SB(0, 0), cB, voffB); PG8_STAGE(PG8_SB(0, 1), cB + hstepB, voffB); PG8_STAGE(PG8_SA(0, 0), cA, voffA); PG8_STAGE(PG8_SA(0, 1), cA + hstepA, voffA);
        if (wr == 1) PG8_BAR;
        PG8_WAIT_V(2); PG8_BAR;
        PG8_STAGE(PG8_SB(1, 0), cB + kstepB, voffB); PG8_STAGE(PG8_SA(1, 0), cA + kstepA, voffA); PG8_STAGE(PG8_SB(1, 1), cB + hstepB + kstepB, voffB);
        PG8_WAIT_V(6); PG8_BAR;
    } else {
        PG8_STAGE(PG8_SB(0, 0), cB, voffB); PG8_STAGE(PG8_SA(0, 0), cA, voffA); PG8_STAGE(PG8_SB(0, 1), cB + hstepB, voffB); PG8_STAGE(PG8_SA(0, 1), cA + hstepA, voffA);
        if (wr == 1) PG8_BAR;
        PG8_WAIT_V(4); PG8_BAR;
        PG8_STAGE(PG8_SB(1, 0), cB + kstepB, voffB); PG8_STAGE(PG8_SA(1, 0), cA + kstepA, voffA); PG8_STAGE(PG8_SB(1, 1), cB + hstepB + kstepB, voffB);
        PG8_WAIT_V(6); PG8_BAR;
    }
    for (;;) {
        const bool has_next = S.next(ui + 1, nxt);
        const char* nA = has_next ? (const char*)g.A + (size_t)nxt.pm * tstepA : cA; const char* nB = has_next ? (const char*)g.Bt + (size_t)nxt.pn * tstepB : cB;
        for (int t = 0; t < nt; t += 2) {
            if constexpr (Epi::HAS_MID) { if (t == nt / 2) E.mid(acc, cur, wr, wc, fr, fq); }
            const bool last = (t == nt - 2);
            const char* a1 = cA + (size_t)(t + 1) * kstepA;
            const char* a2 = last ? nA : cA + (size_t)(t + 2) * kstepA; const char* b2 = last ? nB : cB + (size_t)(t + 2) * kstepB;
            const char* a3 = a2 + kstepA; const char* b3 = b2 + kstepB;
            if (last && has_next) S.a_ready(nxt);
            if constexpr (SP2) {
            PG8_LDB(B0, 0, 0); PG8_LDB(B1, 0, 1); PG8_SCHED; PG8_LDA(At, 0, 0); PG8_STAGE(PG8_SA(1, 1), a1 + hstepA, voffA);
            PG8_WAIT_V(8); PG8_WAIT_L(0); PG8_BAR; PG8_MMA(0, 0, At, B0); PG8_MMA(0, 1, At, B1); PG8_BAR; PG8_SCHED;
            PG8_LDA(At, 0, 1); PG8_STAGE(PG8_SB(0, 0), b2, voffB); PG8_STAGE(PG8_SB(0, 1), b2 + hstepB, voffB); PG8_STAGE(PG8_SA(0, 0), a2, voffA);
            PG8_WAIT_V(8); PG8_WAIT_L(0); PG8_BAR; PG8_MMA(1, 0, At, B0); PG8_MMA(1, 1, At, B1); PG8_BAR; PG8_SCHED;
            PG8_LDB(B0, 1, 0); PG8_LDB(B1, 1, 1); PG8_SCHED; PG8_LDA(At, 1, 0); PG8_STAGE(PG8_SA(0, 1), a2 + hstepA, voffA);
            PG8_WAIT_V(8); PG8_WAIT_L(0); PG8_BAR; PG8_MMA(0, 0, At, B0); PG8_MMA(0, 1, At, B1); PG8_BAR; PG8_SCHED;
            PG8_LDA(At, 1, 1); PG8_STAGE(PG8_SB(1, 0), b3, voffB); PG8_STAGE(PG8_SB(1, 1), b3 + hstepB, voffB); PG8_STAGE(PG8_SA(1, 0), a3, voffA);
            PG8_WAIT_V(8); PG8_WAIT_L(0); PG8_BAR; PG8_MMA(1, 0, At, B0); PG8_MMA(1, 1, At, B1); PG8_BAR; PG8_SCHED;
            } else {
            PG8_LDB(B0, 0, 0); PG8_SCHED; PG8_LDA(At, 0, 0); PG8_STAGE(PG8_SA(1, 1), a1 + hstepA, voffA);
            PG8_WAIT_L(8); PG8_BAR; PG8_WAIT_L(0); PG8_MMA(0, 0, At, B0); PG8_BAR; PG8_SCHED;
            PG8_LDB(B1, 0, 1); PG8_STAGE(PG8_SB(0, 0), b2, voffB);
            PG8_BAR; PG8_WAIT_L(0); PG8_MMA(0, 1, At, B1); PG8_BAR;
            PG8_LDA(At, 0, 1); PG8_STAGE(PG8_SA(0, 0), a2, voffA);
            PG8_BAR; PG8_WAIT_L(0); PG8_MMA(1, 0, At, B0); PG8_BAR; PG8_SCHED;
            PG8_STAGE(PG8_SB(0, 1), b2 + hstepB, voffB);
            PG8_WAIT_V(6); PG8_BAR; PG8_MMA(1, 1, At, B1); PG8_BAR;
            PG8_LDB(B0, 1, 0); PG8_SCHED; PG8_LDA(At, 1, 0); PG8_STAGE(PG8_SA(0, 1), a2 + hstepA, voffA);
            PG8_WAIT_L(8); PG8_BAR; PG8_WAIT_L(0); PG8_MMA(0, 0, At, B0); PG8_BAR; PG8_SCHED;
            PG8_LDB(B1, 1, 1); PG8_STAGE(PG8_SB(1, 0), b3, voffB);
            PG8_BAR; PG8_WAIT_L(0); PG8_MMA(0, 1, At, B1); PG8_BAR;
            PG8_LDA(At, 1, 1); PG8_STAGE(PG8_SA(1, 0), a3, voffA);
            PG8_BAR; PG8_WAIT_L(0); PG8_MMA(1, 0, At, B0); PG8_BAR; PG8_SCHED;
            PG8_STAGE(PG8_SB(1, 1), b3 + hstepB, voffB);
            PG8_WAIT_V(6); PG8_BAR; PG8_MMA(1, 1, At, B1); PG8_BAR;
            }
        }
        if constexpr (F8 == 1) asm volatile("s_nop 15\n\ts_nop 15" ::: "memory");
        if constexpr (ALIGN_EPI) { if (wr == 0) PG8_BAR; }
        if constexpr (Epi::INLOOP) { static_assert(!Epi::INLOOP || ALIGN_EPI, "in-loop fused epilogues need both halves aligned"); E.fused(acc, cur, wr, wc, fr, fq, wid, lane); S.done(cur); }
        else if constexpr (!Epi::AFTER_DRAIN) { E(acc, cur, wr, wc, fr, fq); S.done(cur); }
        if (!has_next) break;
#pragma unroll
        for (int a = 0; a < 2; ++a)
#pragma unroll
            for (int b = 0; b < 2; ++b)
#pragma unroll
                for (int m = 0; m < 4; ++m)
#pragma unroll
                    for (int n = 0; n < 2; ++n) acc[a][b][m][n] = (f32x4){0.f, 0.f, 0.f, 0.f};
        cur = nxt; cA = nA; cB = nB; ++ui;
        if constexpr (ALIGN_EPI) { if (wr == 1) PG8_BAR; }
    }
    PG8_WAIT_V(0);
    if constexpr (!ALIGN_EPI) { if (wr == 0) PG8_BAR; }
    PG8_BAR;
    if constexpr (Epi::AFTER_DRAIN) { E.fused(acc, cur, wr, wc, fr, fq, lds, wid, lane); S.done(cur); }
#undef PG8_SA
#undef PG8_SB
#undef PG8_STAGE
#undef PG8_LDA
#undef PG8_LDB
#undef PG8_MMA
#undef PG8_WAIT_V
#undef PG8_WAIT_L
#undef PG8_BAR
#undef PG8_SCHED
}
}

#ifndef PG8_SP2
#define PG8_SP2 true
#endif
#ifndef PG8_ALIGN
#define PG8_ALIGN true
#endif

constexpr int NWAVES = 8;
#ifndef WGM_P1
#define WGM_P1 4
#endif
#ifndef WGM_P3
#define WGM_P3 4
#endif
#ifndef MK_N_LAUNCHES
#define MK_N_LAUNCHES 1
#endif
constexpr int N_LAUNCHES = MK_N_LAUNCHES;
constexpr int PER_PHASE = 6;

constexpr int DM = 1024, NTOK = 98304, MP = 98560, NPROJ = 5376, N_PROMPT_ROWS = 32768, META_ROW = 98304;
constexpr int COL_QA = 0, COL_KA = 512, COL_VA = 1024, COL_ZA = 1536, COL_QB = 2048, COL_KB = 2560, COL_VB = 2688, COL_ZB = 2816, COL_GA = 3328, COL_GB = 4352;
constexpr int SLOT_QA = 0, SLOT_KA = 8, SLOT_VA = 16, SLOT_QB = 24, SLOT_KB = 32, SLOT_VB = 34, SLOT_ZA = 36, SLOT_ZB = 44, N_SLOTS = 52, SLOT_MERGED = 0;
constexpr size_t SLOT_ELEMS = (size_t)MP * 64;
constexpr float RMS_EPS = 1e-6f;
constexpr float LOG2E = 1.4426950408889634f;
constexpr float C2 = 0.125f * LOG2E;

constexpr size_t MiB = 1u << 20;
constexpr size_t WS_CTL = 0, CTL_ZERO_BYTES = 1 * MiB;
constexpr size_t WS_P = 1 * MiB;
constexpr size_t WS_G = WS_P + (size_t)N_SLOTS * SLOT_ELEMS * 2;
constexpr size_t WS_WP = WS_P + (size_t)MP * NPROJ * 2;
constexpr size_t WS_WO = WS_WP + 2 * MiB;
constexpr size_t WS_TAB = WS_WO + 2 * MiB;
constexpr size_t TAB_RPB = 0, TAB_T5 = 16384, TAB_SINK = 32768;
constexpr size_t WS_XB = WS_TAB + 65536;
constexpr size_t WS_SU = WS_XB + (size_t)NTOK * 4 * 8;
constexpr size_t WS_SW = WS_SU + 512 * 1024;
constexpr size_t WS_XB2 = WS_SW + 32 * 1024;
constexpr size_t WS_SU2 = WS_XB2 + (size_t)NTOK * 4 * 8;
constexpr size_t WS_SWO = WS_SU2 + 512 * 1024;
constexpr size_t WS_END = WS_SWO + 4096;
static_assert(WS_END <= 1073741824ull, "d_ws map exceeds the guaranteed 1 GiB");
constexpr size_t DO_AB8 = 0;
constexpr size_t DO_W8I = 256 * MiB;
constexpr size_t DO_U8 = 272 * MiB;
constexpr size_t DO_WP8 = 372 * MiB;
constexpr float WP8_SCALE = 32.0f, AB8_SCALE = 8.0f;
static_assert(DO_AB8 + (size_t)8 * MP * 128 <= DO_W8I && DO_W8I + (size_t)NPROJ * DM <= DO_U8 && DO_U8 + (size_t)MP * DM <= DO_WP8 && DO_WP8 + (size_t)1024 * DM <= (size_t)NTOK * DM * 4, "d_out scratch map");
constexpr int CW_TMO = 0, CW_CODE = 1, CW_BAR = 4096, CW_SEAM = 16384;

constexpr int RING_OFF = 0, RING_BYTES = 131072;
constexpr int LDSCTL_OFF = RING_BYTES, MISC_OFF = LDSCTL_OFF + 320;
constexpr int LDS_BYTES = 157696;
constexpr int EPI_AUX_OFF = 132096;

#define GAS __attribute__((address_space(1)))
#define LAS __attribute__((address_space(3)))
typedef unsigned short bf16;
typedef unsigned v4u __attribute__((ext_vector_type(4)));
typedef float f32x4 __attribute__((ext_vector_type(4)));
typedef GAS unsigned gu32;
#define RLX_AGENT __ATOMIC_RELAXED, __HIP_MEMORY_SCOPE_AGENT
#define LDS_WAIT() asm volatile("s_waitcnt lgkmcnt(0)" ::: "memory")
#define VM_WAIT() asm volatile("s_waitcnt vmcnt(0)" ::: "memory")
__device__ __forceinline__ unsigned f2bf(float f) { unsigned u = __builtin_bit_cast(unsigned, f); return (u + 0x7fffu + ((u >> 16) & 1u)) >> 16; }
__device__ __forceinline__ unsigned pk2(float lo, float hi) { return f2bf(lo) | (f2bf(hi) << 16); }
__device__ __forceinline__ float bfl(unsigned w) { return __uint_as_float(w << 16); }
__device__ __forceinline__ float bfh(unsigned w) { return __uint_as_float(w & 0xffff0000u); }

#define XB_TMO      128
#define XB_XCNT(j)  (256  + 64 * (j))
#define XB_XSUB(j)  (1280 + 64 * (j))
#define XB_XGEN(j)  (2304 + 64 * (j))
#define XB_TOP      3328
#define XB_TOPGEN   3392
#define XCD_BAR_WORDS 3456
#define XB_SPIN_CAP (1u << 23)
__device__ __forceinline__ unsigned xb_ld(unsigned* p)              { return __hip_atomic_load(p, __ATOMIC_RELAXED, __HIP_MEMORY_SCOPE_AGENT); }
__device__ __forceinline__ unsigned xb_add(unsigned* p, unsigned v) { return __hip_atomic_fetch_add(p, v, __ATOMIC_RELAXED, __HIP_MEMORY_SCOPE_AGENT); }
__device__ __forceinline__ unsigned xb_xcc_id() { return (unsigned)__builtin_amdgcn_s_getreg((3 << 11) | 20) & 0xFu; }
#define XB_SPIN(cond, bar) do { unsigned _sp = 0; while (cond) { __builtin_amdgcn_s_sleep(1); \
    if ((++_sp & 255u) == 0u) { if (xb_ld(&(bar)[XB_TMO])) break; if (_sp > XB_SPIN_CAP) { atomicAdd(&(bar)[XB_TMO], 1u); break; } } } } while (0)
struct XcdBarrier { unsigned* bar; unsigned x; volatile LAS unsigned* st; };
__device__ __forceinline__ XcdBarrier xcd_barrier_post(unsigned* bar, volatile LAS unsigned* st) {
    XcdBarrier b; b.bar = bar; b.x = xb_xcc_id(); b.st = st;
    if (threadIdx.x == 0) (void)xb_add(&bar[XB_XCNT(b.x)], 1u);
    return b;
}
__device__ __forceinline__ void xcd_barrier_complete(unsigned* bar, unsigned x, unsigned& nloc, unsigned& nx) {
    const unsigned G = gridDim.x * gridDim.y * gridDim.z;
    unsigned sum, cnt, mine, sp = 0u;
    for (;;) {
        sum = 0u; cnt = 0u; mine = 0u;
#pragma unroll
        for (unsigned j = 0; j < 16; ++j) { const unsigned c = xb_ld(&bar[XB_XCNT(j)]); sum += c; cnt += (c > 0u) ? 1u : 0u; mine = (j == x) ? c : mine; }
        if (sum == G) break;
        __builtin_amdgcn_s_sleep(1);
        if ((++sp & 255u) == 0u) { if (xb_ld(&bar[XB_TMO])) break; if (sp > XB_SPIN_CAP) { atomicAdd(&bar[XB_TMO], 1u); break; } }
    }
    nloc = mine > 0u ? mine : 1u; nx = cnt > 0u ? cnt : 1u;
}
__device__ __forceinline__ void xcd_barrier(const XcdBarrier& b) {
    asm volatile("s_waitcnt vmcnt(0)" ::: "memory");
    __syncthreads();
    if (threadIdx.x == 0) {
        unsigned* bar = b.bar;
        __builtin_amdgcn_s_waitcnt(0);
        unsigned nloc = b.st[0], nx = b.st[1];
        if (nloc == 0u) { xcd_barrier_complete(bar, b.x, nloc, nx); b.st[0] = nloc; b.st[1] = nx; }
        const unsigned old = xb_add(&bar[XB_XSUB(b.x)], 1u);
        const unsigned gen = old / nloc;
        if (old + 1u == (gen + 1u) * nloc) {
            __builtin_amdgcn_fence(__ATOMIC_RELEASE, "agent");
            asm volatile("s_waitcnt vmcnt(0)" ::: "memory");
            const unsigned og = xb_add(&bar[XB_TOP], 1u);
            const unsigned tg = og / nx;
            if (og + 1u == (tg + 1u) * nx) xb_add(&bar[XB_TOPGEN], 1u);
            else XB_SPIN(xb_ld(&bar[XB_TOPGEN]) == tg, bar);
            __builtin_amdgcn_fence(__ATOMIC_ACQUIRE, "agent");
            xb_add(&bar[XB_XGEN(b.x)], 1u);
            asm volatile("s_waitcnt vmcnt(0)" ::: "memory");
        } else {
            XB_SPIN(xb_ld(&bar[XB_XGEN(b.x)]) == gen, bar);
            __builtin_amdgcn_fence(__ATOMIC_ACQUIRE, "agent");
            asm volatile("s_waitcnt vmcnt(0)" ::: "memory");
        }
    }
    __syncthreads();
}

struct Frame {
    LAS unsigned char* lds;
    volatile LAS unsigned* MISC;
    gu32* ctl;
    int tid, lane, wave;
    int vcu, G;
    const float *xp, *xs, *meta, *norm_g, *w_in, *na_rpb, *sink, *wpa, *wpb, *wout, *t5, *final_g;
    float* out;
    bf16 *P, *Gt; unsigned char *U8, *Wp8, *AB8; signed char *W8i, *Wo8i; float *su, *sw, *su2, *swo;
    float *rpbL2, *t5L2, *sinkL2;
    unsigned char *xslots_a, *xslots_b;
};

__device__ __forceinline__ unsigned pk4_fp8(float a, float b, float c, float d) { int w = __builtin_amdgcn_cvt_pk_fp8_f32(a, b, 0, false); w = __builtin_amdgcn_cvt_pk_fp8_f32(c, d, w, true); return (unsigned)w; }
__device__ __forceinline__ void p0_transpose_item_f8(const float* W, int K, int N, unsigned char* WT8, int ldt, int row_off, int col_off, const float* gk, float sc, LAS float* scr, int item, int lane) {
    const int nblk = N / 32, kb = item / nblk, nb = item % nblk, k0 = 64 * kb, n0 = 32 * nb;
#pragma unroll 8
    for (int i = 0; i < 32; ++i) { const int kk = 2 * i + (lane >> 5); scr[kk * 33 + (lane & 31)] = W[(size_t)(k0 + kk) * N + n0 + (lane & 31)] * (gk ? gk[k0 + kk] * sc : sc); }
    LDS_WAIT(); asm volatile("" ::: "memory");
    const int c = lane & 7;
#pragma unroll
    for (int j = 0; j < 4; ++j) { const int n = (lane >> 3) + 8 * j; const LAS float* s = scr + (8 * c) * 33 + n;
        const unsigned lo = pk4_fp8(s[0 * 33], s[1 * 33], s[2 * 33], s[3 * 33]), hi = pk4_fp8(s[4 * 33], s[5 * 33], s[6 * 33], s[7 * 33]);
        *(GAS unsigned long long*)(WT8 + (size_t)(row_off + n0 + n) * ldt + col_off + k0 + 8 * c) = (unsigned long long)lo | ((unsigned long long)hi << 32); }
    LDS_WAIT(); asm volatile("" ::: "memory");
}
__device__ __forceinline__ int t5_bucket(int rel) {
    const int n = rel < 0 ? -rel : rel; const int base = rel > 0 ? 16 : 0;
    if (n < 8) return base + n;
    int lg = 2 + (31 - __builtin_clz((unsigned)(n * n)));
    return base + (lg < 15 ? lg : 15);
}
__device__ __forceinline__ unsigned pk4_i8(float a, float b, float c, float d) {
    const int ia = __float2int_rn(a), ib = __float2int_rn(b), ic = __float2int_rn(c), id = __float2int_rn(d);
    return (unsigned)(ia & 0xff) | ((unsigned)(ib & 0xff) << 8) | ((unsigned)(ic & 0xff) << 16) | ((unsigned)(id & 0xff) << 24);
}
__device__ __forceinline__ void row_to_i8(Frame& F, int m, const f32x4 (&v)[4], float sumsq, float absmax) {
    const float r = 1.0f / sqrtf(sumsq * (1.f / DM) + RMS_EPS), am = absmax * r;
    const float inv = am > 0.f ? 127.0f / am : 0.f, k = r * inv;
    GAS unsigned* o4 = (GAS unsigned*)(F.U8 + (size_t)m * DM) + F.lane;
#pragma unroll
    for (int j = 0; j < 4; ++j) o4[64 * j] = pk4_i8(v[j].x * k, v[j].y * k, v[j].z * k, v[j].w * k);
    if (F.lane == 0) F.su[m] = am * (1.0f / 127.0f);
}
__device__ __forceinline__ void p0_weight_block_i8(Frame& F, const float* W, int N, int nb, int khalf, const float* gk, float cs, int delta, signed char* W8, float* Sc, LAS float* scr) {
    const int n0 = 32 * nb, lane = F.lane;
    const int lr = lane >> 3, lc = 4 * (lane & 7);
    const GAS float* wp = (const GAS float*)(W + (size_t)lr * N + n0 + lc);
    f32x4 m4 = {0.f, 0.f, 0.f, 0.f};
#pragma unroll 32
    for (int i = 0; i < DM / 8; ++i) { const f32x4 w = *(const GAS f32x4*)(wp + (size_t)(8 * i) * N); const float g = gk ? gk[8 * i + lr] : 1.0f;
        m4.x = fmaxf(m4.x, fabsf(w.x * g)); m4.y = fmaxf(m4.y, fabsf(w.y * g)); m4.z = fmaxf(m4.z, fabsf(w.z * g)); m4.w = fmaxf(m4.w, fabsf(w.w * g)); }
#pragma unroll
    for (int o = 8; o < 64; o <<= 1) { m4.x = fmaxf(m4.x, __shfl_xor(m4.x, o)); m4.y = fmaxf(m4.y, __shfl_xor(m4.y, o)); m4.z = fmaxf(m4.z, __shfl_xor(m4.z, o)); m4.w = fmaxf(m4.w, __shfl_xor(m4.w, o)); }
    LAS float* invs = scr + 64 * 33;
    if (lane < 8) {
#pragma unroll
        for (int e = 0; e < 4; ++e) { const float mx = m4[e] * cs; invs[lc + e] = mx > 0.f ? 127.0f * cs / mx : 0.f; if (khalf == 0) Sc[n0 + delta + lc + e] = mx * (1.0f / 127.0f); } }
    LDS_WAIT(); asm volatile("" ::: "memory");
    for (int kb = 4 * khalf; kb < 4 * khalf + 4; ++kb) { const int k0 = 64 * kb;
#pragma unroll
        for (int i = 0; i < 8; ++i) { const int kk = lr + 8 * i; const f32x4 w = *(const GAS f32x4*)(wp + (size_t)(k0 + 8 * i) * N); const float g = gk ? gk[k0 + kk] : 1.0f;
            scr[kk * 33 + lc + 0] = w.x * g; scr[kk * 33 + lc + 1] = w.y * g; scr[kk * 33 + lc + 2] = w.z * g; scr[kk * 33 + lc + 3] = w.w * g; }
        LDS_WAIT(); asm volatile("" ::: "memory");
        const int c = lane & 7;
#pragma unroll
        for (int j = 0; j < 4; ++j) { const int n = (lane >> 3) + 8 * j; const LAS float* sp = scr + (8 * c) * 33 + n; const float iv = invs[n];
            const unsigned lo = pk4_i8(sp[0 * 33] * iv, sp[1 * 33] * iv, sp[2 * 33] * iv, sp[3 * 33] * iv), hi = pk4_i8(sp[4 * 33] * iv, sp[5 * 33] * iv, sp[6 * 33] * iv, sp[7 * 33] * iv);
            *(GAS unsigned long long*)(W8 + (size_t)(n0 + delta + n) * DM + k0 + 8 * c) = (unsigned long long)lo | ((unsigned long long)hi << 32); }
        LDS_WAIT(); asm volatile("" ::: "memory"); }
}
__device__ __forceinline__ void p0_prologue(Frame& F) {
    LAS float* scr = (LAS float*)(F.lds + RING_OFF + F.wave * 16384);
    const int gw = F.vcu * NWAVES + F.wave, NGW = F.G * NWAVES;
    constexpr int I_IN = 4 * (NPROJ / 32), I_O = 4 * (DM / 32), I_PA = (512 / 64) * (DM / 32), I_PB = I_PA;
    constexpr int NITEMS = I_IN + I_O + I_PA + I_PB;
    for (int it = gw; it < NITEMS; it += NGW) {
        int r = it;
        if (r < I_IN) { const int nb = r >> 2, n0 = 32 * nb; const bool isq = (n0 < COL_KA) || (n0 >= COL_QB && n0 < COL_KB);
            const int delta = (n0 >= COL_ZA && n0 < COL_QB) ? (2304 - COL_ZA) : (n0 >= COL_QB && n0 < COL_ZB) ? -512 : 0;
            p0_weight_block_i8(F, F.w_in, NPROJ, nb, r & 3, F.norm_g, isq ? C2 : 1.0f, delta, F.W8i, F.sw, scr); continue; } r -= I_IN;
        if (r < I_O) { p0_weight_block_i8(F, F.wout, DM, r >> 2, r & 3, nullptr, 1.0f, 0, F.Wo8i, F.swo, scr); continue; } r -= I_O;
        if (r < I_PA) { p0_transpose_item_f8(F.wpa, 512, DM, F.Wp8, DM, 0, 0, nullptr, WP8_SCALE, scr, r, F.lane); continue; } r -= I_PA;
        p0_transpose_item_f8(F.wpb, 512, DM, F.Wp8, DM, 0, 512, nullptr, WP8_SCALE, scr, r, F.lane);
    }
    { const f32x4 z4 = {0.f, 0.f, 0.f, 0.f}; constexpr int N16 = NTOK * 4 * 8 / 16;
      for (int i = F.vcu * (NWAVES * 64) + F.tid; i < N16; i += F.G * NWAVES * 64) { ((GAS f32x4*)F.xslots_a)[i] = z4; ((GAS f32x4*)F.xslots_b)[i] = z4; } }
    for (int m0 = gw; m0 < NTOK; m0 += 4 * NGW) {
        f32x4 v[4][4]; float ss[4], mx[4];
#pragma unroll
        for (int q = 0; q < 4; ++q) { const int m = m0 + q * NGW; const int mc = m < NTOK ? m : m0;
            const GAS f32x4* xr = (const GAS f32x4*)(mc < N_PROMPT_ROWS ? F.xp + (size_t)mc * DM : F.xs + (size_t)(mc - N_PROMPT_ROWS) * DM) + F.lane;
#pragma unroll
            for (int j = 0; j < 4; ++j) v[q][j] = __builtin_nontemporal_load(xr + 64 * j); }
#pragma unroll
        for (int q = 0; q < 4; ++q) { float a = 0.f, b = 0.f;
#pragma unroll
            for (int j = 0; j < 4; ++j) { a += (v[q][j].x * v[q][j].x + v[q][j].y * v[q][j].y) + (v[q][j].z * v[q][j].z + v[q][j].w * v[q][j].w);
                b = fmaxf(b, fmaxf(fmaxf(fabsf(v[q][j].x), fabsf(v[q][j].y)), fmaxf(fabsf(v[q][j].z), fabsf(v[q][j].w)))); }
            ss[q] = a; mx[q] = b; }
#pragma unroll
        for (int o = 1; o < 64; o <<= 1) {
#pragma unroll
            for (int q = 0; q < 4; ++q) { ss[q] += __shfl_xor(ss[q], o); mx[q] = fmaxf(mx[q], __shfl_xor(mx[q], o)); } }
#pragma unroll
        for (int q = 0; q < 4; ++q) { const int m = m0 + q * NGW; if (m < NTOK) row_to_i8(F, m, v[q], ss[q], mx[q]); }
    }
    for (int m = NTOK + gw; m < MP; m += NGW) {
        f32x4 v[4]; float a = 0.f, b = 0.f;
        if (m < NTOK + 16) { const GAS f32x4* xr = (const GAS f32x4*)(F.meta + (size_t)(m - NTOK) * DM) + F.lane;
#pragma unroll
            for (int j = 0; j < 4; ++j) { v[j] = xr[64 * j]; a += (v[j].x * v[j].x + v[j].y * v[j].y) + (v[j].z * v[j].z + v[j].w * v[j].w);
                b = fmaxf(b, fmaxf(fmaxf(fabsf(v[j].x), fabsf(v[j].y)), fmaxf(fabsf(v[j].z), fabsf(v[j].w)))); } }
        else {
#pragma unroll
            for (int j = 0; j < 4; ++j) v[j] = (f32x4){0.f, 0.f, 0.f, 0.f}; }
#pragma unroll
        for (int o = 1; o < 64; o <<= 1) { a += __shfl_xor(a, o); b = fmaxf(b, __shfl_xor(b, o)); }
        row_to_i8(F, m, v, a, b);
    }
    if (blockIdx.x == 0) {
        for (int i = F.tid; i < 8 * 15 * 31; i += NWAVES * 64) F.rpbL2[i] = F.na_rpb[i] * LOG2E;
        for (int i = F.tid; i < 8 * 257; i += NWAVES * 64) { const int h = i / 257, rel = i % 257 - 128; F.t5L2[i] = F.t5[t5_bucket(rel) * 8 + h] * LOG2E; }
        if (F.tid < 8) F.sinkL2[F.tid] = F.sink[F.tid] * LOG2E;
    }
}
__device__ __forceinline__ void batch_of(int t, int& tb, int& n) { if (t < N_PROMPT_ROWS) { tb = t & ~16383; n = 16384; } else { tb = N_PROMPT_ROWS + ((t - N_PROMPT_ROWS) & ~4095); n = 4096; } }
typedef short bf16x8_t __attribute__((ext_vector_type(8)));
typedef short s16x4_t __attribute__((ext_vector_type(4)));
typedef unsigned long long u64_t;
typedef unsigned v2u __attribute__((ext_vector_type(2)));
__device__ __forceinline__ f32x4 mfma16(bf16x8_t a, bf16x8_t b, f32x4 c) { return __builtin_amdgcn_mfma_f32_16x16x32_bf16(a, b, c, 0, 0, 0); }
__device__ __forceinline__ unsigned cvtpk(float lo, float hi) { typedef float f2 __attribute__((ext_vector_type(2))); typedef __bf16 b2 __attribute__((ext_vector_type(2))); f2 v = {lo, hi}; b2 b = __builtin_convertvector(v, b2); return __builtin_bit_cast(unsigned, b); }
__device__ __forceinline__ void k_store(LAS unsigned char* img, int r, int c, v4u w) { *(LAS v4u*)(img + r * 128 + ((c ^ (r & 7)) << 4)) = w; }
__device__ __forceinline__ void v_store(LAS unsigned char* img, int r, int c, v4u w) { *(LAS v4u*)(img + r * 128 + ((c ^ ((r >> 1) & 3)) << 4)) = w; }
__device__ __forceinline__ s16x4_t v_tr_at(const LAS unsigned char* p) {
    typedef short v4i16_t __attribute__((ext_vector_type(4)));
    return __builtin_bit_cast(s16x4_t, __builtin_amdgcn_ds_read_tr16_b64_v4i16((LAS v4i16_t*)p));
}
__device__ __forceinline__ void dma16(const void* g, LAS unsigned char* l) {
    const unsigned la = __builtin_amdgcn_readfirstlane((unsigned)(unsigned long long)l);
    asm volatile("s_mov_b32 m0, %0\n\ts_nop 0\n\tglobal_load_lds_dwordx4 %1, off" :: "s"(la), "v"(g) : "memory", "m0");
}
struct FragOff { int k[2]; int v[4]; };
__device__ __forceinline__ FragOff frag_off(int lane) {
    const int fr = lane & 15, fq = lane >> 4, vr = 4 * (lane >> 4) + ((lane & 15) >> 2), vp = lane & 3; FragOff f;
#pragma unroll
    for (int ks = 0; ks < 2; ++ks) f.k[ks] = fr * 128 + (((4 * ks + fq) ^ (fr & 7)) << 4);
#pragma unroll
    for (int T = 0; T < 4; ++T) f.v[T] = vr * 128 + (((T + 4 * (vp >> 1)) ^ ((vr >> 1) & 3)) << 4) + 8 * (vp & 1);
    return f;
}
__device__ __forceinline__ float max3f(float a, float b, float c) { float r; asm("v_max3_f32 %0, %1, %2, %3" : "=v"(r) : "v"(a), "v"(b), "v"(c)); return r; }
__device__ __forceinline__ float softmax18(f32x4 (&s)[18], float extra) {
    float m0 = extra, m1 = s[0][0], m2 = s[0][1], m3 = s[0][2];
    m0 = max3f(m0, s[0][3], s[1][0]); m1 = max3f(m1, s[1][1], s[1][2]); m2 = max3f(m2, s[1][3], s[2][0]); m3 = max3f(m3, s[2][1], s[2][2]); m0 = max3f(m0, s[2][3], s[3][0]); m1 = max3f(m1, s[3][1], s[3][2]); m2 = max3f(m2, s[3][3], s[3][3]);
#pragma unroll
    for (int t = 4; t < 18; t += 2) { m0 = max3f(m0, s[t][0], s[t][1]); m1 = max3f(m1, s[t][2], s[t][3]); m2 = max3f(m2, s[t + 1][0], s[t + 1][1]); m3 = max3f(m3, s[t + 1][2], s[t + 1][3]); }
    float m = max3f(m0, m1, m2); m = fmaxf(m, m3);
    m = fmaxf(m, __shfl_xor(m, 16)); m = fmaxf(m, __shfl_xor(m, 32));
    if (__any(!(fabsf(m) <= 60.0f))) {
#pragma unroll
        for (int t = 0; t < 18; ++t) {
#pragma unroll
            for (int r = 0; r < 4; ++r) s[t][r] = __builtin_amdgcn_exp2f(s[t][r] - m); }
        return m;
    }
#pragma unroll
    for (int t = 0; t < 18; ++t) {
#pragma unroll
        for (int r = 0; r < 4; ++r) s[t][r] = __builtin_amdgcn_exp2f(s[t][r]); }
    return 0.0f;
}
struct GroupQ { bf16x8_t qf[2]; };
struct GroupZ { v2u zw[4]; };
__device__ __forceinline__ GroupQ load_q(const bf16* qp  ) { GroupQ q; q.qf[0] = *(const GAS bf16x8_t*)qp; q.qf[1] = *(const GAS bf16x8_t*)(qp + 32); return q; }
__device__ __forceinline__ GroupZ load_z(const bf16* zp  ) { GroupZ z;
#pragma unroll
    for (int T = 0; T < 4; ++T) z.zw[T] = *(const GAS v2u*)(zp + 8 * T);
    return z; }
__device__ __forceinline__ void gate_store(const GroupZ& gz, unsigned char* op  , const f32x4 (&o)[4], float rl) {
    const float rs = rl * AB8_SCALE;
#pragma unroll
    for (int T = 0; T < 4; ++T) { const v2u w = gz.zw[T]; const float z[4] = {bfl(w.x), bfh(w.x), bfl(w.y), bfh(w.y)}; float rr[4];
#pragma unroll
        for (int e = 0; e < 4; ++e) { const float sg = __builtin_amdgcn_rcpf(1.0f + __builtin_amdgcn_exp2f(-LOG2E * z[e])); rr[e] = o[T][e] * rs * z[e] * sg; }
        *(GAS unsigned*)(op + 8 * T) = pk4_fp8(rr[0], rr[1], rr[2], rr[3]); }
}
__device__ __forceinline__ void gate_pack(const GroupZ& gz, const f32x4 (&o)[4], float rl, unsigned (&pk)[4]) {
    const float rs = rl * AB8_SCALE;
#pragma unroll
    for (int T = 0; T < 4; ++T) { const v2u w = gz.zw[T]; const float z[4] = {bfl(w.x), bfh(w.x), bfl(w.y), bfh(w.y)}; float rr[4];
#pragma unroll
        for (int e = 0; e < 4; ++e) { const float sg = __builtin_amdgcn_rcpf(1.0f + __builtin_amdgcn_exp2f(-LOG2E * z[e])); rr[e] = o[T][e] * rs * z[e] * sg; }
        pk[T] = pk4_fp8(rr[0], rr[1], rr[2], rr[3]); }
}
__device__ __forceinline__ void gate_put(unsigned char* op, const unsigned (&pk)[4]) {
#pragma unroll
    for (int T = 0; T < 4; ++T) *(GAS unsigned*)(op + 8 * T) = pk[T];
}
__device__ __forceinline__ void q_dma(const bf16* qp  , LAS unsigned char* qslot) { dma16(qp, qslot); dma16(qp + 32, qslot + 1024); }
__device__ __forceinline__ GroupQ q_read(const LAS unsigned char* qslot, int lane) { GroupQ q; q.qf[0] = *(const LAS bf16x8_t*)(qslot + lane * 16); q.qf[1] = *(const LAS bf16x8_t*)(qslot + 1024 + lane * 16); return q; }
#define PV_STEP(ksx, PT0, PT1) do { \
        v4u pw; pw.x = cvtpk(s[2 * (ksx)][0], s[2 * (ksx)][1]); pw.y = cvtpk(s[2 * (ksx)][2], s[2 * (ksx)][3]); pw.z = cvtpk(s[2 * (ksx) + 1][0], s[2 * (ksx) + 1][1]); pw.w = cvtpk(s[2 * (ksx) + 1][2], s[2 * (ksx) + 1][3]); \
        const bf16x8_t pf = __builtin_bit_cast(bf16x8_t, pw); \
        _Pragma("unroll") for (int T = 0; T < 4; ++T) { const s16x4_t lo = v_tr_at(PT0), hi = v_tr_at(PT1); \
            const bf16x8_t vf = (bf16x8_t){lo[0], lo[1], lo[2], lo[3], hi[0], hi[1], hi[2], hi[3]}; o[T] = mfma16(vf, pf, o[T]); } \
        osum = mfma16(ones8, pf, osum); } while (0)
#define S_PHASE(LDPAIR) do { bf16x8_t kf[2][4]; f32x4 bb[2][2]; LDPAIR(0, 0); \
        _Pragma("unroll") for (int pr = 0; pr < 9; ++pr) { if (pr + 1 < 9) LDPAIR((pr + 1) & 1, pr + 1); \
            f32x4 aa = bb[pr & 1][0], ab = bb[pr & 1][1]; \
            aa = mfma16(kf[pr & 1][0], gq.qf[0], aa); ab = mfma16(kf[pr & 1][2], gq.qf[0], ab); aa = mfma16(kf[pr & 1][1], gq.qf[1], aa); ab = mfma16(kf[pr & 1][3], gq.qf[1], ab); \
            s[2 * pr] = aa; s[2 * pr + 1] = ab; __builtin_amdgcn_sched_barrier(0); } } while (0)
#define WAITV(n) asm volatile("s_waitcnt vmcnt(" #n ")" ::: "memory")
#define BARRIER() do { asm volatile("s_waitcnt lgkmcnt(0)" ::: "memory"); __builtin_amdgcn_s_barrier(); asm volatile("" ::: "memory"); } while (0)

constexpr int NA_KROWS = 11, NA_COLS = 40, NA_WROWS = NA_KROWS * NA_COLS, NA_MROW = 448, NA_IMG_ROWS = 464;
constexpr int NA_IMG_BYTES = NA_IMG_ROWS * 128;
struct NaStep { int tb, rows, i0, h, half, krow0, colbase; };
__device__ __forceinline__ NaStep na_decode(int idx) {
    NaStep s; int hh, st;
    if (idx < 2048) { s.tb = (idx >> 10) * 16384; s.rows = 256; const int rem = idx & 1023; hh = rem >> 6; st = rem & 63; }
    else { const int i2 = idx - 2048; s.tb = N_PROMPT_ROWS + (i2 >> 8) * 4096; s.rows = 64; const int rem = i2 & 255; hh = rem >> 4; st = rem & 15; }
    s.h = hh >> 1; s.half = hh & 1; s.i0 = 4 * st; s.krow0 = min(max(s.i0 - 4, 0), s.rows - 8); s.colbase = s.half ? 24 : 0; return s;
}
template <bool FULL> __device__ __forceinline__ void na_dma_issue(const bf16* P, const NaStep& s, int k0m, LAS unsigned char* img, int slot0, int chunk, int wave, int lane) {
    const bf16* base = P + ((size_t)(slot0 + s.h) * MP + s.tb + s.colbase + (lane >> 3)) * 64 + 8 * chunk;
#pragma unroll
    for (int j = 0; j < (FULL ? 7 : 3); ++j) { int krl, cb;
        if (FULL) { int B = 7 * wave + j; if (B > 54) B = 54; krl = B / 5; cb = B - 5 * krl; }
        else { int b = wave + 8 * j; if (b >= 20) b -= 20; krl = b / 5; cb = b - 5 * krl; krl += 7; }
        int slot = k0m + krl; if (slot >= 11) slot -= 11;
        const int kr = min(s.krow0 + krl, s.rows - 1);
        dma16(base + (size_t)(kr * 64 + 8 * cb) * 64, img + (slot * 5 + cb) * 1024); }
}
__device__ __forceinline__ void stage_meta(LAS unsigned char* kimg, LAS unsigned char* vimg, int mrow0, const bf16* P, int kslot, int vslot, int tid) {
    if (tid < 128) { const int m = tid >> 3, c = tid & 7; const size_t ro = (size_t)(META_ROW + m) * 64 + 8 * c;
        k_store(kimg, mrow0 + m, c, *(const GAS v4u*)(P + (size_t)kslot * SLOT_ELEMS + ro)); v_store(vimg, mrow0 + m, c, *(const GAS v4u*)(P + (size_t)vslot * SLOT_ELEMS + ro)); }
}
__device__ __forceinline__ void na_build_table(LAS float* tbl4, const float* rpbL2, int h, int tid) {
    for (int u = tid; u < 4 * 15 * 64; u += NWAVES * 64) { const int rem = u / (15 * 64), ri = (u / 64) % 15, k = (u & 63) + rem - 16; tbl4[u] = (k >= 0 && k <= 30) ? rpbL2[(h * 15 + ri) * 31 + k] : 0.f; }
}
struct NaGeo { int i, jg, rs, c0; size_t tq; };
__device__ __forceinline__ NaGeo na_geo(const NaStep& st, int wave, int lane) {
    NaGeo g; g.i = st.i0 + (wave >> 1); g.jg = 2 * st.half + (wave & 1); g.rs = min(max(g.i - 4, 0), st.rows - 8); g.c0 = min(max(16 * g.jg - 8, 0), 32);
    g.tq = (size_t)(st.tb + g.i * 64 + 16 * g.jg + (lane & 15)); return g;
}

constexpr int WA_IMG_ROWS = 400, WA_IMG_BYTES = WA_IMG_ROWS * 128, WA_OPS = 6;
constexpr int WA_TBL = 296;
struct WaUnit { int t0, tb, n, tl0, kh; };
__device__ __forceinline__ WaUnit wa_decode(int blk, int kh) { WaUnit u; u.t0 = blk * 128; batch_of(u.t0, u.tb, u.n); u.tl0 = u.t0 - u.tb; u.kh = kh; return u; }
__device__ __forceinline__ void wa_dma_issue(const bf16* P, const WaUnit& u, LAS unsigned char* img, int slot0, int chunk, int wave, int lane) {
    const bf16* base = P + ((size_t)(slot0 + u.kh) * MP + u.tb) * 64 + 8 * chunk;
#pragma unroll
    for (int j = 0; j < WA_OPS; ++j) { const int row = 8 * (WA_OPS * wave + j) + (lane >> 3), kl = min(max(u.tl0 - 128 + row, 0), u.n - 1);
        dma16(base + (size_t)kl * 64, img + (WA_OPS * wave + j) * 1024); }
}
__device__ __forceinline__ void wa_build_table(LAS float* tblw, const float* t5L2, int kh, int tid) {
    for (int u = tid; u < 16 * WA_TBL; u += NWAVES * 64) { const int g = u / (4 * WA_TBL), rem = (u / WA_TBL) & 3, idx = (u % WA_TBL) + rem - 16; tblw[u] = (idx >= 0 && idx <= 256) ? t5L2[(4 * kh + g) * 257 + idx] : -1e30f; }
}

constexpr int TAB_LDS_OFF = 132096;
__device__ __forceinline__ void p2_attention(Frame& F) {
    if (F.G != 256) return;
    const int x = F.vcu >> 5, w = F.vcu & 31;
    const int lane = F.lane, wave = F.wave, fr = lane & 15, fq = lane >> 4, dlane = 32 * (fq >> 1) + 4 * (fq & 1);
    const int ck = (lane & 7) ^ (lane >> 3), cv = (lane & 7) ^ ((lane >> 4) & 3);
    const FragOff fo = frag_off(lane);
    const bf16x8_t ones8 = (bf16x8_t){0x3F80, 0x3F80, 0x3F80, 0x3F80, 0x3F80, 0x3F80, 0x3F80, 0x3F80};
    {
        LAS unsigned char* kimg = F.lds + RING_OFF; LAS unsigned char* vimg = F.lds + RING_OFF + NA_IMG_BYTES; LAS float* tbl4 = (LAS float*)(F.lds + TAB_LDS_OFF);
        int cur_h = -1;
        NaStep st = na_decode(768 * x + 24 * w); NaGeo ge = na_geo(st, wave, lane);
        int k0m = st.krow0 % 11, nk = 7;
        LAS unsigned char* const qslot = F.lds + (wave < 6 ? RING_OFF + 2 * NA_IMG_BYTES + wave * 2048 : TAB_LDS_OFF + 15360 + (wave - 6) * 2048);
        na_dma_issue<true>(F.P, st, k0m, kimg, SLOT_KA, ck, wave, lane);
        q_dma(F.P + ((size_t)(SLOT_QA + st.h) * MP + ge.tq) * 64 + 8 * fq, qslot);
        na_dma_issue<true>(F.P, st, k0m, vimg, SLOT_VA, cv, wave, lane);
        for (int r = 0; r < 24; ++r) {
            if (st.h != cur_h) { na_build_table(tbl4, F.rpbL2, st.h, F.tid); stage_meta(kimg, vimg, NA_MROW, F.P, SLOT_KA + st.h, SLOT_VA + st.h, F.tid); cur_h = st.h; }
            const int i = ge.i, jg = ge.jg, rs = ge.rs, c0 = ge.c0, j = 16 * jg + fr, cs = min(max(j - 8, 0), 48);
            const int cpart = (c0 - st.colbase) * 128;
            int rsm = k0m + (rs - st.krow0); if (rsm >= 11) rsm -= 11;
#define NA_SO(a_) (((rsm + (a_)) >= 11 ? rsm + (a_) - 11 : rsm + (a_)) * (NA_COLS * 128))
            const LAS unsigned char* kb0 = kimg + cpart + fo.k[0]; const LAS unsigned char* kb1 = kimg + cpart + fo.k[1];
            const LAS unsigned char* km0 = kimg + NA_MROW * 128 + fo.k[0]; const LAS unsigned char* km1 = kimg + NA_MROW * 128 + fo.k[1];
            bool ok[2][4];
#pragma unroll
            for (int xx = 0; xx < 2; ++xx)
#pragma unroll
                for (int e = 0; e < 4; ++e) { const int col = c0 + 16 * xx + 4 * fq + e; ok[xx][e] = (col >= cs) && (col <= cs + 15); }
            const int idx0 = c0 - 16 * jg + 15 - fr + 16 + 4 * fq, rem = idx0 & 3;
            const LAS float* bp = tbl4 + rem * (15 * 64) + (rs - i + 7) * 64 + (idx0 - rem);
            const size_t tq = ge.tq; const int hcur = st.h;
            f32x4 s[18];
            if (r > 0 && nk == 7) WAITV(11); else WAITV(7);
            BARRIER();
            const GroupQ gq = q_read(qslot, lane);
#define NA_LDPAIR(buf, p) do { if ((p) < 8) { const f32x4 b0_ = *(const LAS f32x4*)(bp + (p) * 64), b1_ = *(const LAS f32x4*)(bp + (p) * 64 + 16); \
                _Pragma("unroll") for (int e = 0; e < 4; ++e) { bb[buf][0][e] = ok[0][e] ? b0_[e] : -1e30f; bb[buf][1][e] = ok[1][e] ? b1_[e] : -1e30f; } \
                kf[buf][0] = *(const LAS bf16x8_t*)(kb0 + NA_SO(p)); kf[buf][1] = *(const LAS bf16x8_t*)(kb1 + NA_SO(p)); \
                kf[buf][2] = *(const LAS bf16x8_t*)(kb0 + NA_SO(p) + 16 * 128); kf[buf][3] = *(const LAS bf16x8_t*)(kb1 + NA_SO(p) + 16 * 128); } \
            else { bb[buf][0] = (f32x4){0.f, 0.f, 0.f, 0.f}; bb[buf][1] = (f32x4){-1e30f, -1e30f, -1e30f, -1e30f}; \
                kf[buf][0] = *(const LAS bf16x8_t*)km0; kf[buf][1] = *(const LAS bf16x8_t*)km1; kf[buf][2] = kf[buf][0]; kf[buf][3] = kf[buf][1]; } } while (0)
            S_PHASE(NA_LDPAIR);
#undef NA_LDPAIR
            s[17] = (f32x4){-1e30f, -1e30f, -1e30f, -1e30f};
            BARRIER();
            const bool more = (r + 1 < 24);
            int nk2 = 7, k0m2 = 0;
            if (more) { const NaStep s2 = na_decode(768 * x + 24 * w + r + 1); const int adv = s2.krow0 - st.krow0;
                const bool inc = (s2.tb == st.tb) && (s2.h == st.h) && (s2.half == st.half) && (adv == 0 || adv == 4);
                st = s2; ge = na_geo(st, wave, lane); k0m2 = st.krow0 % 11; nk2 = inc ? 3 : 7;
                if (inc) na_dma_issue<false>(F.P, st, k0m2, kimg, SLOT_KA, ck, wave, lane); else na_dma_issue<true>(F.P, st, k0m2, kimg, SLOT_KA, ck, wave, lane);
                q_dma(F.P + ((size_t)(SLOT_QA + st.h) * MP + ge.tq) * 64 + 8 * fq, qslot); }
            bf16* const zp = F.P + ((size_t)(SLOT_ZA + hcur) * MP + tq) * 64 + dlane; GroupZ gz = load_z(zp);
            asm volatile("" ::: "memory");
            (void)softmax18(s, -1e30f);
            if (!more) WAITV(8); else if (r == 0) { if (nk2 == 7) WAITV(13); else WAITV(9); } else { if (nk2 == 7) WAITV(17); else WAITV(13); }
            BARRIER();
            f32x4 o[4], osum = {0.f, 0.f, 0.f, 0.f};
#pragma unroll
            for (int T = 0; T < 4; ++T) o[T] = (f32x4){0.f, 0.f, 0.f, 0.f};
            { const LAS unsigned char* vb = vimg + cpart; const LAS unsigned char* vm = vimg + NA_MROW * 128;
#pragma unroll
              for (int a = 0; a < 8; ++a) PV_STEP(a, vb + NA_SO(a) + fo.v[T], vb + NA_SO(a) + 16 * 128 + fo.v[T]);
              PV_STEP(8, vm + fo.v[T], vm + fo.v[T]); }
            asm volatile("" : "+v"(gz.zw[0]), "+v"(gz.zw[1]), "+v"(gz.zw[2]), "+v"(gz.zw[3]));
            BARRIER();
            const float rl = __builtin_amdgcn_rcpf(osum[0]);
            unsigned pk[4]; gate_pack(gz, o, rl, pk);
            if (more) { if (nk2 == 3) na_dma_issue<false>(F.P, st, k0m2, vimg, SLOT_VA, cv, wave, lane); else na_dma_issue<true>(F.P, st, k0m2, vimg, SLOT_VA, cv, wave, lane); }
            nk = nk2; k0m = k0m2;
            asm volatile("" ::: "memory");
            gate_put(F.AB8 + ((size_t)(hcur >> 1) * MP + tq) * 128 + 64 * (hcur & 1) + dlane, pk);
#undef NA_SO
        }
        WAITV(0); __syncthreads();
    }
    {
        LAS unsigned char* kimg = F.lds + RING_OFF; LAS unsigned char* vimg = F.lds + RING_OFF + WA_IMG_BYTES; LAS float* tblw = (LAS float*)(F.lds + TAB_LDS_OFF);
        const int kh = w & 1, g = wave >> 1, hq = 4 * kh + g, qb = 64 * (wave & 1); const float sinkv = F.sinkL2[hq]; const float* tb5 = F.t5L2 + hq * 257; const float tb50 = tb5[0];
        LAS unsigned char* const qslot = F.lds + RING_OFF + 2 * WA_IMG_BYTES + wave * 2048;
        wa_build_table(tblw, F.t5L2, kh, F.tid); stage_meta(kimg, vimg, 384, F.P, SLOT_KB + kh, SLOT_VB + kh, F.tid);
        WaUnit u = wa_decode(96 * x + 6 * (w >> 1), kh);
        wa_dma_issue(F.P, u, kimg, SLOT_KB, ck, wave, lane);
        q_dma(F.P + ((size_t)(SLOT_QB + hq) * MP + u.t0 + qb + fr) * 64 + 8 * fq, qslot);
        wa_dma_issue(F.P, u, vimg, SLOT_VB, cv, wave, lane);
        const int idx0 = 16 + 4 * fq - fr, rem = idx0 & 3;
        const LAS float* bp = tblw + (g * 4 + rem) * WA_TBL + (idx0 - rem);
        const LAS unsigned char* km0 = kimg + 384 * 128 + fo.k[0]; const LAS unsigned char* km1 = kimg + 384 * 128 + fo.k[1];
        for (int r = 0; r < 6; ++r) {
            const WaUnit cur = u; const bool more = (r + 1 < 6);
            if (r == 0) WAITV(6); else WAITV(14);
            BARRIER();
            _Pragma("nounroll") for (int gi = 0; gi < 4; ++gi) {
                const int q0 = qb + 16 * gi, tg0 = q0 >> 4, qq = q0 + fr; const size_t tq = (size_t)(cur.t0 + qq);
                const LAS unsigned char* kb0 = kimg + (16 * tg0) * 128 + fo.k[0]; const LAS unsigned char* kb1 = kimg + (16 * tg0) * 128 + fo.k[1];
                if (gi > 0) WAITV(8);
                const GroupQ gq = q_read(qslot, lane);
                f32x4 mb = (f32x4){tb50, tb50, tb50, tb50};
                if (cur.tl0 < 128) {
#pragma unroll
                    for (int e = 0; e < 4; ++e) { const int nn = min(cur.tl0 + qq + 16 - (4 * fq + e), 128); mb[e] = tb5[128 - nn]; }
                    asm volatile("" : "+v"(mb));
                    WAITV(0); }
                f32x4 s[18];
#define WA_LDPAIR(buf, p) do { bb[buf][0] = *(const LAS f32x4*)(bp + 32 * (p)); kf[buf][0] = *(const LAS bf16x8_t*)(kb0 + (p) * 4096); kf[buf][1] = *(const LAS bf16x8_t*)(kb1 + (p) * 4096); \
                if ((p) < 8) { bb[buf][1] = *(const LAS f32x4*)(bp + 32 * (p) + 16); kf[buf][2] = *(const LAS bf16x8_t*)(kb0 + (p) * 4096 + 2048); kf[buf][3] = *(const LAS bf16x8_t*)(kb1 + (p) * 4096 + 2048); } \
                else { bb[buf][1] = mb; kf[buf][2] = *(const LAS bf16x8_t*)km0; kf[buf][3] = *(const LAS bf16x8_t*)km1; } } while (0)
                S_PHASE(WA_LDPAIR);
#undef WA_LDPAIR
                if (cur.tl0 == 0) {
#pragma unroll
                    for (int tl = 0; tl < 17; ++tl) if (tg0 + tl < 8) s[tl] = (f32x4){-1e30f, -1e30f, -1e30f, -1e30f}; }
                if (cur.tl0 + 128 == cur.n) {
#pragma unroll
                    for (int tl = 0; tl < 17; ++tl) if (tg0 + tl >= 16) s[tl] = (f32x4){-1e30f, -1e30f, -1e30f, -1e30f}; }
                if (gi == 3) { BARRIER();
                    if (more) { u = wa_decode(96 * x + 6 * (w >> 1) + r + 1, kh); wa_dma_issue(F.P, u, kimg, SLOT_KB, ck, wave, lane); q_dma(F.P + ((size_t)(SLOT_QB + hq) * MP + u.t0 + qb + fr) * 64 + 8 * fq, qslot); } }
                else q_dma(F.P + ((size_t)(SLOT_QB + hq) * MP + tq + 16) * 64 + 8 * fq, qslot);
                bf16* const zp = F.P + ((size_t)(SLOT_ZB + hq) * MP + tq) * 64 + dlane; GroupZ gz = load_z(zp);
                asm volatile("" ::: "memory");
                const float moff = softmax18(s, sinkv);
                if (gi == 0) { if (r == 0) WAITV(6); else WAITV(10); BARRIER(); }
                f32x4 o[4], osum = {0.f, 0.f, 0.f, 0.f};
#pragma unroll
                for (int T = 0; T < 4; ++T) o[T] = (f32x4){0.f, 0.f, 0.f, 0.f};
                { const LAS unsigned char* vb = vimg + (16 * tg0) * 128; const LAS unsigned char* vm = vimg + 384 * 128;
#pragma unroll
                  for (int ksx = 0; ksx < 8; ++ksx) PV_STEP(ksx, vb + (32 * ksx) * 128 + fo.v[T], vb + (32 * ksx + 16) * 128 + fo.v[T]);
                  PV_STEP(8, vb + 256 * 128 + fo.v[T], vm + fo.v[T]); }
                asm volatile("" : "+v"(gz.zw[0]), "+v"(gz.zw[1]), "+v"(gz.zw[2]), "+v"(gz.zw[3]));
                if (gi == 3) BARRIER();
                const float rl = __builtin_amdgcn_rcpf(osum[0] + __builtin_amdgcn_exp2f(sinkv - moff));
                unsigned pk[4]; gate_pack(gz, o, rl, pk);
                if (gi == 3 && more) wa_dma_issue(F.P, u, vimg, SLOT_VB, cv, wave, lane);
                asm volatile("" ::: "memory");
                gate_put(F.AB8 + ((size_t)(4 + (hq >> 1)) * MP + tq) * 128 + 64 * (hq & 1) + dlane, pk);
            }
        }
        WAITV(0); __syncthreads();
    }
}
#undef PV_STEP
#undef S_PHASE
#undef WAITV
#undef BARRIER
struct Args { const float* in[12]; float* out; unsigned char* ws; int ph_lo, ph_hi, li, pad; };
__global__ void __launch_bounds__(NWAVES * 64, 2) mk_fwd(Args args) {
    extern __shared__ __attribute__((aligned(16))) unsigned char lds[];
    Frame F;
    F.lds = (LAS unsigned char*)lds;
    F.MISC = (volatile LAS unsigned*)(F.lds + MISC_OFF);
    F.tid = threadIdx.x; F.lane = F.tid & 63; F.wave = __builtin_amdgcn_readfirstlane(F.tid >> 6);
    F.G = gridDim.x; { const int bx = blockIdx.x; F.vcu = (F.G % 8 == 0) ? (bx % 8) * (F.G / 8) + bx / 8 : bx; }
    unsigned char* ws = args.ws;
    F.ctl = (gu32*)(ws + WS_CTL);
    F.xp = args.in[0]; F.xs = args.in[1]; F.meta = args.in[2]; F.norm_g = args.in[3]; F.w_in = args.in[4]; F.na_rpb = args.in[5]; F.sink = args.in[6];
    F.wpa = args.in[7]; F.wpb = args.in[8]; F.wout = args.in[9]; F.t5 = args.in[10]; F.final_g = args.in[11]; F.out = args.out;
    F.P = (bf16*)(ws + WS_P); F.Gt = (bf16*)(ws + WS_G);
    F.U8 = (unsigned char*)args.out + DO_U8; F.W8i = (signed char*)args.out + DO_W8I; F.Wp8 = (unsigned char*)args.out + DO_WP8; F.AB8 = (unsigned char*)args.out + DO_AB8;
    F.Wo8i = (signed char*)ws + WS_WO; F.su = (float*)(ws + WS_SU); F.sw = (float*)(ws + WS_SW); F.su2 = (float*)(ws + WS_SU2); F.swo = (float*)(ws + WS_SWO);
    F.xslots_a = ws + WS_XB; F.xslots_b = ws + WS_XB2;
    F.rpbL2 = (float*)(ws + WS_TAB + TAB_RPB); F.t5L2 = (float*)(ws + WS_TAB + TAB_T5); F.sinkL2 = (float*)(ws + WS_TAB + TAB_SINK);
    for (int u = F.tid; u < (LDS_BYTES - LDSCTL_OFF) / 4; u += NWAVES * 64) ((LAS unsigned*)(F.lds + LDSCTL_OFF))[u] = 0u;
    __syncthreads();
    XcdBarrier bar; bar.bar = (unsigned*)(F.ctl + CW_BAR); bar.x = 0; bar.st = nullptr;
    if (N_LAUNCHES != PER_PHASE) bar = xcd_barrier_post((unsigned*)(F.ctl + CW_BAR), F.MISC + 8);
#define GRID_BAR() do { if (N_LAUNCHES != PER_PHASE) xcd_barrier(bar); } while (0)
    const int lo = args.ph_lo, hi = args.ph_hi;
#define IN(k) (lo <= (k) && (k) < hi)
#define BOTH(k) (IN(k) && IN((k) + 1))
    if (IN(0)) { p0_prologue(F); if (BOTH(0)) GRID_BAR(); }
    if (IN(1)) { {
        { pg8::Gemm g{(const bf16*)F.U8, (const bf16*)F.W8i, MP, NPROJ, DM / 2, DM / 2, DM / 2, 128}; pg8::StaticOrder S; S.init(MP, NPROJ, F.G, (int)blockIdx.x, WGM_P1);
          pg8::EpiI8 E{F.P, F.Gt, F.su, F.sw, MP};
          pg8::gemm_phase<pg8::EpiI8, pg8::StaticOrder, PG8_ALIGN, PG8_SP2, 2>(F.lds + RING_OFF, g, S, E, F.wave); } }
        if (BOTH(1)) GRID_BAR();
    }
    if (IN(2)) {
        p2_attention(F);
        if (BOTH(2)) GRID_BAR();
    }
    if (IN(3)) { {
        { pg8::Gemm g{(const bf16*)F.AB8, (const bf16*)F.Wp8, NTOK, DM, DM / 2, 64, DM / 2, (size_t)MP * 128}; pg8::StaticOrder S; S.init(NTOK, DM, F.G, (int)blockIdx.x, WGM_P3);
          pg8::PanelStat<true> stm{(unsigned*)(ws + WS_XB2), (unsigned*)(F.ctl + CW_SEAM + 32768), (unsigned*)(F.ctl + CW_TMO), F.lds + EPI_AUX_OFF};
          pg8::EpiGate2 E{F.P + SLOT_MERGED * SLOT_ELEMS, F.Gt, MP, 1.0f / (WP8_SCALE * AB8_SCALE), stm, F.su2};
          pg8::gemm_phase<pg8::EpiGate2, pg8::StaticOrder, true, PG8_SP2, 1>(F.lds + RING_OFF, g, S, E, F.wave); } }
        if (BOTH(3)) GRID_BAR();
    }
    if (IN(4)) { {
        pg8::Gemm g{F.P + SLOT_MERGED * SLOT_ELEMS, (const bf16*)F.Wo8i, NTOK, DM, DM / 2, 64, DM / 2, (size_t)MP * 128}; pg8::StaticOrder S; S.init(NTOK, DM, F.G, (int)blockIdx.x, WGM_P3);
        pg8::PanelStat<false> st{(unsigned*)(ws + WS_XB), (unsigned*)(F.ctl + CW_SEAM), (unsigned*)(F.ctl + CW_TMO), F.lds + EPI_AUX_OFF};
        pg8::EpiResNorm E{F.xp, F.xs, N_PROMPT_ROWS, F.final_g, F.out, DM, st, F.su2, F.swo};
        pg8::gemm_phase<pg8::EpiResNorm, pg8::StaticOrder, true, PG8_SP2, 2>(F.lds + RING_OFF, g, S, E, F.wave); }
        if (BOTH(4)) GRID_BAR();
    }
#undef IN
#undef BOTH
}

extern "C" void kernel_launch(void* const* d_in, const int* in_sizes, int n_in, void* d_out, int out_size, void* d_ws, size_t ws_size, hipStream_t stream) {
    static int grid = 0;
    if (grid == 0) {
        if (n_in != 12 || out_size != NTOK * DM || ws_size < WS_END) { fprintf(stderr, "kernel_launch: unexpected shapes: n_in %d out %d ws %zu (need %zu)\n", n_in, out_size, ws_size, (size_t)WS_END); grid = -1; return; }
        int dev = 0, cus = 0;
        if (hipGetDevice(&dev) != hipSuccess || hipDeviceGetAttribute(&cus, hipDeviceAttributeMultiprocessorCount, dev) != hipSuccess) { grid = -1; return; }
        if (hipFuncSetAttribute((const void*)mk_fwd, hipFuncAttributeMaxDynamicSharedMemorySize, LDS_BYTES) != hipSuccess) { fprintf(stderr, "kernel_launch: hipFuncSetAttribute failed\n"); grid = -1; return; }
        (void)hipGetLastError();
        grid = cus;
    }
    if (grid < 0) return;
    (void)hipMemsetAsync((char*)d_ws + WS_CTL, 0, CTL_ZERO_BYTES, stream);
    Args a{};
    for (int i = 0; i < 12; ++i) a.in[i] = (const float*)d_in[i];
    a.out = (float*)d_out; a.ws = (unsigned char*)d_ws;
    for (int li = 0; li < N_LAUNCHES; ++li) {
        a.ph_lo = (N_LAUNCHES == PER_PHASE) ? li : 0; a.ph_hi = (N_LAUNCHES == PER_PHASE) ? li + 1 : PER_PHASE; a.li = li;
        hipLaunchKernelGGL(mk_fwd, dim3(grid), dim3(NWAVES * 64), LDS_BYTES, stream, a);
    }
}
```
